# Optimizing an MI355X kernel written in HIP

```python
import math
import jax, jax.numpy as jnp
from jax import lax
import numpy as np

D_MODEL = 2048
BATCH = 2
SEQ = 4096
DEPTH = 1

SSM_EXPAND = 2
D_INNER = SSM_EXPAND * D_MODEL
SSM_HEAD_DIM = 64
SSM_HEADS = D_INNER // SSM_HEAD_DIM
SSM_GROUPS = 8
SSM_HEADS_PER_GROUP = SSM_HEADS // SSM_GROUPS
SSM_STATE = 128
SSM_CONV = 4
SSM_CONV_DIM = D_INNER + 2 * SSM_GROUPS * SSM_STATE
CHUNK = 128
SB_HEADS = 16
SB_HEAD_DIM = 128
SB_WIDTH = SB_HEADS * SB_HEAD_DIM
Q_BLOCK = 128
N_BRANCHES = 2
FFN_DIM = 5632
FFN_CONV = 3
EPS = 1e-6

_SPLIT_SIZES = [D_INNER, SSM_CONV_DIM, SSM_HEADS, SB_WIDTH, SB_WIDTH, SB_WIDTH, N_BRANCHES * D_MODEL]
D_IN_PROJ = sum(_SPLIT_SIZES)
SPLIT_IDX = [int(v) for v in np.cumsum(_SPLIT_SIZES)[:-1]]

kernel_name = "hybrid_ssd_stickbreaking_convffn"


def rms_norm(x, w):
    xf = x.astype(jnp.float32)
    y = xf * lax.rsqrt(jnp.mean(xf * xf, axis=-1, keepdims=True) + EPS)
    return (y * w.astype(jnp.float32)).astype(x.dtype)


def causal_dwconv(x, w, b):
    K = w.shape[0]
    S = x.shape[1]
    xp = jnp.pad(x, ((0, 0), (K - 1, 0), (0, 0)))
    y = b
    for k in range(K):
        y = y + w[k] * xp[:, k:k + S, :]
    return y


def ssd_chunked(x, dt, a_neg, Bm, Cm):
    b, l, h, p = x.shape
    G, E, N = SSM_GROUPS, SSM_HEADS_PER_GROUP, SSM_STATE
    nc = l // CHUNK
    dtype = x.dtype
    xc = x.reshape(b, nc, CHUNK, G, E, p)
    dtc = dt.reshape(b, nc, CHUNK, G, E)
    Bc = Bm.reshape(b, nc, CHUNK, G, N)
    Cc = Cm.reshape(b, nc, CHUNK, G, N)
    a = dtc.astype(jnp.float32) * a_neg.reshape(G, E).astype(jnp.float32)
    a = jnp.moveaxis(a, 2, -1)
    acs = jnp.cumsum(a, axis=-1)
    idx = jnp.arange(CHUNK)
    causal = idx[:, None] >= idx[None, :]
    seg = acs[..., :, None] - acs[..., None, :]
    Lmat = jnp.exp(jnp.where(causal, seg, -jnp.inf)).astype(dtype)
    xdt = xc * dtc[..., None]
    cb = jnp.einsum('bcqgn,bcsgn->bcgqs', Cc, Bc)
    y_diag = jnp.einsum('bcgqs,bcgeqs,bcsgep->bcqgep', cb, Lmat, xdt)
    decay_states = jnp.exp(acs[..., -1:] - acs).astype(dtype)
    states = jnp.einsum('bcsgn,bcges,bcsgep->bcgepn', Bc, decay_states, xdt)
    chunk_decay = jnp.exp(acs[..., -1]).astype(dtype)

    def step(hstate, inp):
        s_c, d_c = inp
        return hstate * d_c[..., None, None] + s_c, hstate

    h0 = jnp.zeros((b, G, E, p, N), dtype)
    _, prev = lax.scan(step, h0, (jnp.moveaxis(states, 1, 0), jnp.moveaxis(chunk_decay, 1, 0)))
    prev = jnp.moveaxis(prev, 0, 1)
    y_off = jnp.einsum('bcqgn,bcgepn,bcgeq->bcqgep', Cc, prev, jnp.exp(acs).astype(dtype))
    return (y_diag + y_off).reshape(b, l, h, p)


def stick_breaking_attention(q, k, v):
    b, h, S, d = q.shape
    nb = S // Q_BLOCK
    scale = 1.0 / math.sqrt(d)
    key_pos = jnp.arange(S)

    def block(i):
        start = i * Q_BLOCK
        qb = lax.dynamic_slice_in_dim(q, start, Q_BLOCK, axis=2)
        z = jnp.einsum('bhqd,bhkd->bhqk', qb, k).astype(jnp.float32) * scale
        q_pos = start + jnp.arange(Q_BLOCK)
        mask = key_pos[None, :] < q_pos[:, None]
        log_beta = jax.nn.log_sigmoid(z)
        log_keep = jnp.where(mask, jax.nn.log_sigmoid(-z), 0.0)
        later = lax.cumsum(log_keep, axis=log_keep.ndim - 1, reverse=True) - log_keep
        att = jnp.where(mask, jnp.exp(log_beta + later), 0.0)
        return jnp.einsum('bhqk,bhkd->bhqd', att.astype(v.dtype), v)

    out = lax.map(block, jnp.arange(nb))
    return jnp.moveaxis(out, 0, 2).reshape(b, h, S, d)


def setup_inputs(seed: int = 0) -> dict:
    key = jax.random.key(seed)
    ks = jax.random.split(key, 24)
    f32 = jnp.float32
    L = DEPTH

    def nrm(k, shape, scale):
        return jax.random.normal(k, shape, f32) * scale

    x = jax.random.normal(ks[0], (BATCH, SEQ, D_MODEL), f32)
    norm1_w = 1.0 + nrm(ks[1], (L, D_MODEL), 0.01)
    w_in = nrm(ks[2], (L, D_MODEL, D_IN_PROJ), D_MODEL ** -0.5)
    conv_ssm_w = nrm(ks[3], (L, SSM_CONV, SSM_CONV_DIM), SSM_CONV ** -0.5)
    conv_ssm_b = nrm(ks[4], (L, SSM_CONV_DIM), 0.01)
    dt0 = jnp.exp(jax.random.uniform(ks[5], (L, SSM_HEADS), f32, math.log(1e-3), math.log(1e-1)))
    dt_bias = dt0 + jnp.log(-jnp.expm1(-dt0))
    a_log = jnp.log(jax.random.uniform(ks[6], (L, SSM_HEADS), f32, 1.0, 16.0))
    d_skip = 1.0 + nrm(ks[7], (L, SSM_HEADS), 0.01)
    ssm_norm_w = 1.0 + nrm(ks[8], (L, D_INNER), 0.01)
    q_norm_w = 1.0 + nrm(ks[9], (L, SB_HEAD_DIM), 0.01)
    k_norm_w = 1.0 + nrm(ks[10], (L, SB_HEAD_DIM), 0.01)
    gate_b = nrm(ks[11], (L, N_BRANCHES * D_MODEL), 0.01)
    w_ssm_out = nrm(ks[12], (L, D_INNER, D_MODEL), D_INNER ** -0.5)
    w_att_out = nrm(ks[13], (L, SB_WIDTH, D_MODEL), SB_WIDTH ** -0.5)
    w_o = nrm(ks[14], (L, D_MODEL, D_MODEL), D_MODEL ** -0.5)
    norm2_w = 1.0 + nrm(ks[15], (L, D_MODEL), 0.01)
    w_up = nrm(ks[16], (L, D_MODEL, 2 * FFN_DIM), D_MODEL ** -0.5)
    conv_ffn_w = nrm(ks[17], (L, FFN_CONV, FFN_DIM), FFN_CONV ** -0.5)
    conv_ffn_b = nrm(ks[18], (L, FFN_DIM), 0.01)
    w_down = nrm(ks[19], (L, FFN_DIM, D_MODEL), FFN_DIM ** -0.5)
    return {"x": x, "norm1_w": norm1_w, "w_in": w_in, "conv_ssm_w": conv_ssm_w,
            "conv_ssm_b": conv_ssm_b, "dt_bias": dt_bias, "a_log": a_log, "d_skip": d_skip,
            "ssm_norm_w": ssm_norm_w, "q_norm_w": q_norm_w, "k_norm_w": k_norm_w,
            "gate_b": gate_b, "w_ssm_out": w_ssm_out, "w_att_out": w_att_out, "w_o": w_o,
            "norm2_w": norm2_w, "w_up": w_up, "conv_ffn_w": conv_ffn_w,
            "conv_ffn_b": conv_ffn_b, "w_down": w_down}


def reference(x, norm1_w, w_in, conv_ssm_w, conv_ssm_b, dt_bias, a_log, d_skip,
              ssm_norm_w, q_norm_w, k_norm_w, gate_b, w_ssm_out, w_att_out, w_o,
              norm2_w, w_up, conv_ffn_w, conv_ffn_b, w_down):
    b, S, _ = x.shape
    for l in range(DEPTH):
        u = rms_norm(x, norm1_w[l])
        proj = u @ w_in[l]
        z, xbc, dt_raw, q, k, v, gate_logits = jnp.split(proj, SPLIT_IDX, axis=-1)

        xbc = jax.nn.silu(causal_dwconv(xbc, conv_ssm_w[l], conv_ssm_b[l]))
        xs, Bm, Cm = jnp.split(xbc, [D_INNER, D_INNER + SSM_GROUPS * SSM_STATE], axis=-1)
        dt = jax.nn.softplus(dt_raw + dt_bias[l])
        a_neg = -jnp.exp(a_log[l])
        xs_h = xs.reshape(b, S, SSM_HEADS, SSM_HEAD_DIM)
        y = ssd_chunked(xs_h, dt, a_neg,
                        Bm.reshape(b, S, SSM_GROUPS, SSM_STATE),
                        Cm.reshape(b, S, SSM_GROUPS, SSM_STATE))
        y = y + d_skip[l][:, None] * xs_h
        y = y.reshape(b, S, D_INNER) * jax.nn.silu(z)
        y = rms_norm(y.reshape(b, S, SSM_GROUPS, D_INNER // SSM_GROUPS),
                     ssm_norm_w[l].reshape(SSM_GROUPS, D_INNER // SSM_GROUPS)).reshape(b, S, D_INNER)
        y_ssm = y @ w_ssm_out[l]

        qh = rms_norm(q.reshape(b, S, SB_HEADS, SB_HEAD_DIM), q_norm_w[l]).transpose(0, 2, 1, 3)
        kh = rms_norm(k.reshape(b, S, SB_HEADS, SB_HEAD_DIM), k_norm_w[l]).transpose(0, 2, 1, 3)
        vh = v.reshape(b, S, SB_HEADS, SB_HEAD_DIM).transpose(0, 2, 1, 3)
        att = stick_breaking_attention(qh, kh, vh)
        y_att = att.transpose(0, 2, 1, 3).reshape(b, S, SB_WIDTH) @ w_att_out[l]

        gates = jax.nn.sigmoid(gate_logits + gate_b[l]).reshape(b, S, N_BRANCHES, D_MODEL)
        mixed = gates[:, :, 0, :] * y_ssm + gates[:, :, 1, :] * y_att
        x = x + mixed @ w_o[l]

        u2 = rms_norm(x, norm2_w[l])
        up = u2 @ w_up[l]
        a_in, g_in = jnp.split(up, [FFN_DIM], axis=-1)
        a_in = causal_dwconv(a_in, conv_ffn_w[l], conv_ffn_b[l])
        x = x + (jax.nn.silu(a_in) * g_in) @ w_down[l]
    return x
```

```cpp
#include <hip/hip_runtime.h>
#include <hip/hip_cooperative_groups.h>
#include <cstdio>
#include <cstdint>
namespace cg = cooperative_groups;
#ifndef MK_N_LAUNCHES
#define MK_N_LAUNCHES 1
#endif
#include <hip/hip_runtime.h>
#include <cstdio>
#include <cstdint>
namespace pg8 {
#define PG8_LAS __attribute__((address_space(3)))
typedef unsigned short bf16_t;
typedef short bf16x8 __attribute__((ext_vector_type(8)));
typedef float f32x4 __attribute__((ext_vector_type(4)));
typedef unsigned u32x4 __attribute__((ext_vector_type(4)));
constexpr int BM = 256, BK = 64, HALF = 128, HTB = HALF * BK * 2  , STAGE_BYTES = 8 * HTB, NXCD = 8, WGM = 8;

__host__ __device__ __forceinline__ int lds_byte(int r, int c) { const int st = (r >> 4) * 2 + (c >> 5), rr = r & 15, cc = c & 31, ob = rr * 64 + cc * 2; return st * 1024 + (ob ^ (((ob >> 9) & 1) << 5)); }
__host__ __device__ __forceinline__ void stage_rc(int b, int& R, int& C) { const int st = b / 1024, sb = b % 1024, swz = sb ^ (((sb >> 9) & 1) << 5); R = (st >> 1) * 16 + swz / 64; C = (st & 1) * 32 + (swz % 64) / 2; }
__host__ __device__ __forceinline__ int perm32(int rho) { const int n = rho >> 4, i = rho & 15; return 8 * (i >> 2) + 4 * n + (i & 3); }

struct Unit { int pm, pn; };
struct Gemm { const bf16_t* A; const bf16_t* Bt; int M, N, K; };

struct StaticOrder {
    int nM, nN, nwg, G, c;
    __host__ __device__ void init(int M, int N, int G_, int c_) { nM = M / BM; nN = N / BM; nwg = nM * nN; G = G_; c = c_; }
    __host__ __device__ bool next(int i, Unit& u) const {
        const long L = (long)i * G + c; if (L >= nwg) return false;
        int wgid = (int)L; { const int q = nwg / NXCD, r = nwg % NXCD, xcd = wgid % NXCD, off = wgid / NXCD; wgid = (xcd < r ? xcd * (q + 1) : r * (q + 1) + (xcd - r) * q) + off; }
        const int nig = WGM * nN, gid = wgid / nig, fm = gid * WGM, gsz = (nM - fm) < WGM ? (nM - fm) : WGM;
        u.pm = fm + ((wgid % nig) % gsz); u.pn = (wgid % nig) / gsz; return true;
    }
    __device__ __forceinline__ void a_ready(const Unit&) const {}
    __device__ __forceinline__ void done(const Unit&) const {}
};

typedef float f32x2 __attribute__((ext_vector_type(2)));
typedef __bf16 bf16x2v __attribute__((ext_vector_type(2)));
__device__ __forceinline__ unsigned cvt_pk_bf16(float lo, float hi) { f32x2 v = {lo, hi}; bf16x2v b = __builtin_convertvector(v, bf16x2v); return __builtin_bit_cast(unsigned, b); }
__device__ __forceinline__ float bflo(unsigned w) { return __uint_as_float(w << 16); }
__device__ __forceinline__ float bfhi(unsigned w) { return __uint_as_float(w & 0xffff0000u); }
__device__ __forceinline__ float sigmoidf_(float v) { return __builtin_amdgcn_rcpf(1.0f + __expf(-v)); }
template <int MODE> struct Epi {
    static constexpr bool PERM = true, AFTER_DRAIN = false;
    bf16_t* O; float* T1; const float* X0; const bf16_t* G; const float* gb; float* rowss; int ldc, ldg, gcol0;
    __device__ __forceinline__ void operator()(const f32x4 (&acc)[2][2][4][2], const Unit& u, int wr, int wc, int fr, int fq) const {
        const int row0 = u.pm * BM + wr * 64 + fr, col0 = u.pn * BM + wc * 32 + 8 * fq;
#pragma unroll
        for (int ai = 0; ai < 2; ++ai)
#pragma unroll
            for (int m = 0; m < 4; ++m) {
                const int row = row0 + ai * HALF + m * 16;
                float rs = 1.f, ssq = 0.f;
                if (MODE == 4) rs = __builtin_amdgcn_rsqf(rowss[row] * (1.0f / 2048.0f) + 1e-6f);
#pragma unroll
                for (int bj = 0; bj < 2; ++bj) {
                    const int col = col0 + bj * HALF; const size_t off = (size_t)row * ldc + col;
                    f32x4 v0 = acc[ai][bj][m][0], v1 = acc[ai][bj][m][1];
                    if (MODE == 1 || MODE == 2) {
                        const u32x4 gw = *(const u32x4*)(G + (size_t)row * ldg + gcol0 + col);
                        const f32x4 b0 = *(const f32x4*)(gb + col), b1 = *(const f32x4*)(gb + col + 4);
                        f32x4 s0, s1;
                        s0[0] = sigmoidf_(bflo(gw[0]) + b0[0]); s0[1] = sigmoidf_(bfhi(gw[0]) + b0[1]); s0[2] = sigmoidf_(bflo(gw[1]) + b0[2]); s0[3] = sigmoidf_(bfhi(gw[1]) + b0[3]);
                        s1[0] = sigmoidf_(bflo(gw[2]) + b1[0]); s1[1] = sigmoidf_(bfhi(gw[2]) + b1[1]); s1[2] = sigmoidf_(bflo(gw[3]) + b1[2]); s1[3] = sigmoidf_(bfhi(gw[3]) + b1[3]);
                        v0 = v0 * s0; v1 = v1 * s1;
                        if (MODE == 1) { u32x4 w; w.x = cvt_pk_bf16(v0[0], v0[1]); w.y = cvt_pk_bf16(v0[2], v0[3]); w.z = cvt_pk_bf16(v1[0], v1[1]); w.w = cvt_pk_bf16(v1[2], v1[3]); *(u32x4*)((bf16_t*)T1 + off) = w; }
                        else { const u32x4 t = *(const u32x4*)((const bf16_t*)T1 + off);
                            v0[0] += bflo(t.x); v0[1] += bfhi(t.x); v0[2] += bflo(t.y); v0[3] += bfhi(t.y); v1[0] += bflo(t.z); v1[1] += bfhi(t.z); v1[2] += bflo(t.w); v1[3] += bfhi(t.w); }
                    }
                    if (MODE == 3) {
                        v0 = v0 + *(const f32x4*)(X0 + off); v1 = v1 + *(const f32x4*)(X0 + off + 4);
                        *(f32x4*)(T1 + off) = v0; *(f32x4*)(T1 + off + 4) = v1;
                        ssq += (v0[0] * v0[0] + v0[1] * v0[1]) + (v0[2] * v0[2] + v0[3] * v0[3]) + (v1[0] * v1[0] + v1[1] * v1[1]) + (v1[2] * v1[2] + v1[3] * v1[3]);
                        v0 = v0 * *(const f32x4*)(gb + col); v1 = v1 * *(const f32x4*)(gb + col + 4);
                    }
                    if (MODE == 4) { v0 = v0 * rs; v1 = v1 * rs; }
                    if (MODE == 5) {
                        v0 = v0 + *(const f32x4*)(T1 + off); v1 = v1 + *(const f32x4*)(T1 + off + 4);
                        *(f32x4*)(T1 + off) = v0; *(f32x4*)(T1 + off + 4) = v1;
                    }
                    if (MODE == 0 || MODE == 2 || MODE == 3 || MODE == 4) {
                        u32x4 w; w.x = cvt_pk_bf16(v0[0], v0[1]); w.y = cvt_pk_bf16(v0[2], v0[3]); w.z = cvt_pk_bf16(v1[0], v1[1]); w.w = cvt_pk_bf16(v1[2], v1[3]);
                        *(u32x4*)(O + off) = w;
                    }
                }
                if (MODE == 3) { ssq += __shfl_xor(ssq, 16); ssq += __shfl_xor(ssq, 32); if (fq == 0) atomicAdd(rowss + row, ssq); }
            }
    }
};

__device__ __forceinline__ float dpp_ror1(float v) { return __builtin_bit_cast(float, __builtin_amdgcn_update_dpp(0, __builtin_bit_cast(int, v), 0x121, 0xf, 0xf, false)); }
__device__ __forceinline__ float dpp_ror2(float v) { return __builtin_bit_cast(float, __builtin_amdgcn_update_dpp(0, __builtin_bit_cast(int, v), 0x122, 0xf, 0xf, false)); }
struct EpiFfn {
    static constexpr bool PERM = true, AFTER_DRAIN = false;
    bf16_t* H; const float* rowss; const float* cw; const float* cb; float* SBHA; float* SBHG; float* SBT;
    __device__ __forceinline__ void operator()(const f32x4 (&acc)[2][2][4][2], const Unit& u, int wr, int wc, int fr, int fq) const {
        constexpr int F = 5632;
        const int j0 = u.pn * HALF + wc * 32 + 8 * fq;
        float w0[8], w1[8], w2[8], bs[8];
#pragma unroll
        for (int h = 0; h < 2; ++h) { const f32x4 a = *(const f32x4*)(cw + j0 + 4 * h), b = *(const f32x4*)(cw + F + j0 + 4 * h), c = *(const f32x4*)(cw + 2 * F + j0 + 4 * h), d = *(const f32x4*)(cb + j0 + 4 * h);
#pragma unroll
            for (int k = 0; k < 4; ++k) { w0[4 * h + k] = a[k]; w1[4 * h + k] = b[k]; w2[4 * h + k] = c[k]; bs[4 * h + k] = d[k]; } }
#pragma unroll
        for (int ai = 0; ai < 2; ++ai) {
            const int R0 = u.pm * BM + ai * HALF + wr * 64, blk = R0 >> 6;
            float ap[8];
#pragma unroll
            for (int k = 0; k < 8; ++k) ap[k] = 0.f;
#pragma unroll
            for (int m = 0; m < 4; ++m) {
                const int row = R0 + 16 * m + fr;
                const float rs = __builtin_amdgcn_rsqf(rowss[row] * (1.0f / 2048.0f) + 1e-6f);
                float av[8], gv[8], hv[8];
#pragma unroll
                for (int k = 0; k < 4; ++k) { av[k] = acc[ai][0][m][0][k] * rs; av[4 + k] = acc[ai][0][m][1][k] * rs; gv[k] = acc[ai][1][m][0][k] * rs; gv[4 + k] = acc[ai][1][m][1][k] * rs; }
#pragma unroll
                for (int k = 0; k < 8; ++k) {
                    const float s1 = dpp_ror1(av[k]), s2 = dpp_ror2(av[k]), p1 = dpp_ror1(ap[k]), p2 = dpp_ror2(ap[k]);
                    const float a1 = fr >= 1 ? s1 : p1, a2 = fr >= 2 ? s2 : p2;
                    const float v = bs[k] + w0[k] * a2 + w1[k] * a1 + w2[k] * av[k];
                    hv[k] = v * __builtin_amdgcn_rcpf(1.0f + __expf(-v)) * gv[k];
                }
                if (m > 0 || fr >= 2) {
                    u32x4 w; w.x = cvt_pk_bf16(hv[0], hv[1]); w.y = cvt_pk_bf16(hv[2], hv[3]); w.z = cvt_pk_bf16(hv[4], hv[5]); w.w = cvt_pk_bf16(hv[6], hv[7]);
                    *(u32x4*)(H + (size_t)row * F + j0) = w;
                } else {
                    const size_t o = ((size_t)blk * 2 + fr) * F + j0;
                    *(f32x4*)(SBHA + o) = (f32x4){av[0], av[1], av[2], av[3]}; *(f32x4*)(SBHA + o + 4) = (f32x4){av[4], av[5], av[6], av[7]};
                    *(f32x4*)(SBHG + o) = (f32x4){gv[0], gv[1], gv[2], gv[3]}; *(f32x4*)(SBHG + o + 4) = (f32x4){gv[4], gv[5], gv[6], gv[7]};
                }
                if (m == 3 && fr >= 14) {
                    const size_t o = ((size_t)blk * 2 + (fr - 14)) * F + j0;
                    *(f32x4*)(SBT + o) = (f32x4){av[0], av[1], av[2], av[3]}; *(f32x4*)(SBT + o + 4) = (f32x4){av[4], av[5], av[6], av[7]};
                }
#pragma unroll
                for (int k = 0; k < 8; ++k) ap[k] = av[k];
            }
        }
    }
};

template <class Epi, class Sched, bool ALIGN_EPI = false, bool SP2 = false>
__device__ __forceinline__ void gemm_phase(PG8_LAS unsigned char* lds, const Gemm g, const Sched& S, const Epi& E) {
    const int tid = threadIdx.x, wid = __builtin_amdgcn_readfirstlane(tid >> 6), lane = tid & 63, wr = wid >> 2, wc = wid & 3, fr = lane & 15, fq = lane >> 4;
    const int K = g.K, nt = K / BK;
    unsigned voffA[2], voffB[2];
#pragma unroll
    for (int i = 0; i < 2; ++i) { int R, C; stage_rc(tid * 16 + i * 8192, R, C); const int Rb = Epi::PERM ? ((R & ~31) + perm32(R & 31)) : R;
        voffA[i] = (unsigned)(R * K + C) * 2u; voffB[i] = (unsigned)(Rb * K + C) * 2u; }
    const size_t kstep = (size_t)(BK * 2);
    const size_t hstep = (size_t)HALF * K * 2;
    const size_t tstep = 2 * hstep;
    const unsigned ldsw = (unsigned)wid * 1024u;
    const int aoff = lds_byte(wr * 64 + fr, fq * 8), boff = lds_byte(wc * 32 + fr, fq * 8);
#define PG8_SA(b, h) (((b) * 2 + (h)) * HTB)
#define PG8_SB(b, h) ((4 + (b) * 2 + (h)) * HTB)
#define PG8_STAGE(bufoff, gbase, voff) do { _Pragma("unroll") for (int _i = 0; _i < 2; ++_i) \
        __builtin_amdgcn_global_load_lds((const unsigned*)((const char*)(gbase) + (voff)[_i]), (PG8_LAS unsigned*)(lds + (bufoff) + ldsw + _i * 8192), 16, 0, 0); } while (0)
#define PG8_LDA(dst, b, h) do { _Pragma("unroll") for (int m = 0; m < 4; ++m) _Pragma("unroll") for (int k = 0; k < 2; ++k) dst[m][k] = *(const PG8_LAS bf16x8*)(lds + PG8_SA(b, h) + aoff + m * 2048 + k * 1024); } while (0)
#define PG8_LDB(dst, b, h) do { _Pragma("unroll") for (int n = 0; n < 2; ++n) _Pragma("unroll") for (int k = 0; k < 2; ++k) dst[n][k] = *(const PG8_LAS bf16x8*)(lds + PG8_SB(b, h) + boff + n * 2048 + k * 1024); } while (0)
#define PG8_MMA(ai, bj, At, Bt) do { __builtin_amdgcn_s_setprio(1); _Pragma("unroll") for (int m = 0; m < 4; ++m) _Pragma("unroll") for (int n = 0; n < 2; ++n) _Pragma("unroll") for (int k = 0; k < 2; ++k) \
        acc[ai][bj][m][n] = __builtin_amdgcn_mfma_f32_16x16x32_bf16(Bt[n][k], At[m][k], acc[ai][bj][m][n], 0, 0, 0); __builtin_amdgcn_s_setprio(0); } while (0)
#define PG8_WAIT_V(n) asm volatile("s_waitcnt vmcnt(" #n ")" ::: "memory")
#define PG8_WAIT_L(n) asm volatile("s_waitcnt lgkmcnt(" #n ")" ::: "memory")
#define PG8_BAR __builtin_amdgcn_s_barrier()
#define PG8_SCHED __builtin_amdgcn_sched_barrier(0)
    Unit cur, nxt; int ui = 0;
    if (!S.next(0, cur)) return;
    f32x4 acc[2][2][4][2];
#pragma unroll
    for (int a = 0; a < 2; ++a)
#pragma unroll
        for (int b = 0; b < 2; ++b)
#pragma unroll
            for (int m = 0; m < 4; ++m)
#pragma unroll
                for (int n = 0; n < 2; ++n) acc[a][b][m][n] = (f32x4){0.f, 0.f, 0.f, 0.f};
    bf16x8 At[4][2], B0[2][2], B1[2][2];
    const char* cA = (const char*)g.A + (size_t)cur.pm * tstep; const char* cB = (const char*)g.Bt + (size_t)cur.pn * tstep;
    S.a_ready(cur);
    if constexpr (SP2) {
        PG8_STAGE(PG8_SB(0, 0), cB, voffB); PG8_STAGE(PG8_SB(0, 1), cB + hstep, voffB); PG8_STAGE(PG8_SA(0, 0), cA, voffA); PG8_STAGE(PG8_SA(0, 1), cA + hstep, voffA);
        if (wr == 1) PG8_BAR;
        PG8_WAIT_V(2); PG8_BAR;
        PG8_STAGE(PG8_SB(1, 0), cB + kstep, voffB); PG8_STAGE(PG8_SA(1, 0), cA + kstep, voffA); PG8_STAGE(PG8_SB(1, 1), cB + hstep + kstep, voffB);
        PG8_WAIT_V(6); PG8_BAR;
    } else {
        PG8_STAGE(PG8_SB(0, 0), cB, voffB); PG8_STAGE(PG8_SA(0, 0), cA, voffA); PG8_STAGE(PG8_SB(0, 1), cB + hstep, voffB); PG8_STAGE(PG8_SA(0, 1), cA + hstep, voffA);
        if (wr == 1) PG8_BAR;
        PG8_WAIT_V(4); PG8_BAR;
        PG8_STAGE(PG8_SB(1, 0), cB + kstep, voffB); PG8_STAGE(PG8_SA(1, 0), cA + kstep, voffA); PG8_STAGE(PG8_SB(1, 1), cB + hstep + kstep, voffB);
        PG8_WAIT_V(6); PG8_BAR;
    }
    for (;;) {
        const bool has_next = S.next(ui + 1, nxt);
        const char* nA = has_next ? (const char*)g.A + (size_t)nxt.pm * tstep : cA; const char* nB = has_next ? (const char*)g.Bt + (size_t)nxt.pn * tstep : cB;
        for (int t = 0; t < nt; t += 2) {
            const bool last = (t == nt - 2);
            const char* a1 = cA + (size_t)(t + 1) * kstep;
            const char* a2 = last ? nA : cA + (size_t)(t + 2) * kstep; const char* b2 = last ? nB : cB + (size_t)(t + 2) * kstep;
            const char* a3 = a2 + kstep; const char* b3 = b2 + kstep;
            if (last && has_next) S.a_ready(nxt);
            if constexpr (SP2) {
            PG8_LDB(B0, 0, 0); PG8_LDB(B1, 0, 1); PG8_SCHED; PG8_LDA(At, 0, 0); PG8_STAGE(PG8_SA(1, 1), a1 + hstep, voffA);
            PG8_WAIT_V(8); PG8_WAIT_L(0); PG8_BAR; PG8_MMA(0, 0, At, B0); PG8_MMA(0, 1, At, B1); PG8_BAR; PG8_SCHED;
            PG8_LDA(At, 0, 1); PG8_STAGE(PG8_SB(0, 0), b2, voffB); PG8_STAGE(PG8_SB(0, 1), b2 + hstep, voffB); PG8_STAGE(PG8_SA(0, 0), a2, voffA);
            PG8_WAIT_V(8); PG8_WAIT_L(0); PG8_BAR; PG8_MMA(1, 0, At, B0); PG8_MMA(1, 1, At, B1); PG8_BAR; PG8_SCHED;
            PG8_LDB(B0, 1, 0); PG8_LDB(B1, 1, 1); PG8_SCHED; PG8_LDA(At, 1, 0); PG8_STAGE(PG8_SA(0, 1), a2 + hstep, voffA);
            PG8_WAIT_V(8); PG8_WAIT_L(0); PG8_BAR; PG8_MMA(0, 0, At, B0); PG8_MMA(0, 1, At, B1); PG8_BAR; PG8_SCHED;
            PG8_LDA(At, 1, 1); PG8_STAGE(PG8_SB(1, 0), b3, voffB); PG8_STAGE(PG8_SB(1, 1), b3 + hstep, voffB); PG8_STAGE(PG8_SA(1, 0), a3, voffA);
            PG8_WAIT_V(8); PG8_WAIT_L(0); PG8_BAR; PG8_MMA(1, 0, At, B0); PG8_MMA(1, 1, At, B1); PG8_BAR; PG8_SCHED;
            } else {
            PG8_LDB(B0, 0, 0); PG8_SCHED; PG8_LDA(At, 0, 0); PG8_STAGE(PG8_SA(1, 1), a1 + hstep, voffA);
            PG8_WAIT_L(8); PG8_BAR; PG8_WAIT_L(0); PG8_MMA(0, 0, At, B0); PG8_BAR; PG8_SCHED;
            PG8_LDB(B1, 0, 1); PG8_STAGE(PG8_SB(0, 0), b2, voffB);
            PG8_BAR; PG8_WAIT_L(0); PG8_MMA(0, 1, At, B1); PG8_BAR;
            PG8_LDA(At, 0, 1); PG8_STAGE(PG8_SA(0, 0), a2, voffA);
            PG8_BAR; PG8_WAIT_L(0); PG8_MMA(1, 0, At, B0); PG8_BAR; PG8_SCHED;
            PG8_STAGE(PG8_SB(0, 1), b2 + hstep, voffB);
            PG8_WAIT_V(6); PG8_BAR; PG8_MMA(1, 1, At, B1); PG8_BAR;
            PG8_LDB(B0, 1, 0); PG8_SCHED; PG8_LDA(At, 1, 0); PG8_STAGE(PG8_SA(0, 1), a2 + hstep, voffA);
            PG8_WAIT_L(8); PG8_BAR; PG8_WAIT_L(0); PG8_MMA(0, 0, At, B0); PG8_BAR; PG8_SCHED;
            PG8_LDB(B1, 1, 1); PG8_STAGE(PG8_SB(1, 0), b3, voffB);
            PG8_BAR; PG8_WAIT_L(0); PG8_MMA(0, 1, At, B1); PG8_BAR;
            PG8_LDA(At, 1, 1); PG8_STAGE(PG8_SA(1, 0), a3, voffA);
            PG8_BAR; PG8_WAIT_L(0); PG8_MMA(1, 0, At, B0); PG8_BAR; PG8_SCHED;
            PG8_STAGE(PG8_SB(1, 1), b3 + hstep, voffB);
            PG8_WAIT_V(6); PG8_BAR; PG8_MMA(1, 1, At, B1); PG8_BAR;
            }
        }
        if constexpr (ALIGN_EPI) { if (wr == 0) PG8_BAR; }
        if constexpr (!Epi::AFTER_DRAIN) { E(acc, cur, wr, wc, fr, fq); S.done(cur); }
        if (!has_next) break;
#pragma unroll
        for (int a = 0; a < 2; ++a)
#pragma unroll
            for (int b = 0; b < 2; ++b)
#pragma unroll
                for (int m = 0; m < 4; ++m)
#pragma unroll
                    for (int n = 0; n < 2; ++n) acc[a][b][m][n] = (f32x4){0.f, 0.f, 0.f, 0.f};
        cur = nxt; cA = nA; cB = nB; ++ui;
        if constexpr (ALIGN_EPI) { if (wr == 1) PG8_BAR; }
    }
    PG8_WAIT_V(0);
    if constexpr (!ALIGN_EPI) { if (wr == 0) PG8_BAR; }
    PG8_BAR;
    if constexpr (Epi::AFTER_DRAIN) { E.fused(acc, cur, wr, wc, fr, fq, lds, wid, lane); S.done(cur); }
#undef PG8_SA
#undef PG8_SB
#undef PG8_STAGE
#undef PG8_LDA
#undef PG8_LDB
#undef PG8_MMA
#undef PG8_WAIT_V
#undef PG8_WAIT_L
#undef PG8_BAR
#undef PG8_SCHED
}
}

#define DI __device__ __forceinline__
#define LAS __attribute__((address_space(3)))
typedef unsigned short bf16_t;
typedef short bf16x8 __attribute__((ext_vector_type(8)));
typedef short s16x4 __attribute__((ext_vector_type(4)));
typedef float f32x4 __attribute__((ext_vector_type(4)));
typedef float f32x16 __attribute__((ext_vector_type(16)));
typedef unsigned u32x4 __attribute__((ext_vector_type(4)));
typedef LAS unsigned char* lptr;
constexpr int NTHR = 512, NWAVES = 8;
constexpr int BATCH = 2, SEQ = 4096, DM = 2048, MTOK = BATCH * SEQ;
constexpr int DIN = 4096, NPROJ = 20736;
constexpr int OFF_Z = 0, OFF_XBC = 4096, OFF_Q = 10240, OFF_K = 12288, OFF_V = 14336, OFF_G = 16384, OFF_DT = 20480;
constexpr int FFN = 5632, NUP = 2 * FFN;
constexpr float EPS = 1e-6f;
constexpr size_t MiB = 1u << 20;
constexpr size_t WS_CTL = 0, WS_WIN = 1 * MiB, WS_WSSM = 82 * MiB, WS_WATT = 98 * MiB, WS_WO = 106 * MiB, WS_WUP = 114 * MiB, WS_WDN = 158 * MiB,
                 WS_U = 180 * MiB, WS_Y = 212 * MiB, WS_PROJ = 276 * MiB, WS_SB = 600 * MiB  , WS_DT = 618 * MiB  , WS_END = 620 * MiB;
constexpr size_t WS_ST = WS_WIN  , WS_MIX = WS_WIN  , WS_H = WS_PROJ  ;
constexpr size_t SB_STRIDE = (size_t)(MTOK / 64) * 2 * FFN * 4;
constexpr size_t CTL_ROWSS = 0, CTL_CD = 65536, CTL_BAR = 131072, CTL_BAR_BYTES = 16384;
constexpr int LDS_BYTES = 150 * 1024;

DI unsigned pk2(float lo, float hi) { return pg8::cvt_pk_bf16(lo, hi); }
DI float bflo(unsigned w) { return __uint_as_float(w << 16); }
DI float bfhi(unsigned w) { return __uint_as_float(w & 0xffff0000u); }
DI float bf1(bf16_t h) { return __uint_as_float((unsigned)h << 16); }
DI float wave_sum(float v) {
#pragma unroll
    for (int o = 1; o < 64; o <<= 1) v += __shfl_xor(v, o);
    return v;
}
DI float siluf_(float v) { return v * __builtin_amdgcn_rcpf(1.0f + __expf(-v)); }
DI float softplusf_(float v) { return fmaxf(v, 0.f) + log1pf(__expf(-fabsf(v))); }
#define MFMA32(a, b, c) __builtin_amdgcn_mfma_f32_32x32x16_bf16((a), (b), (c), 0, 0, 0)
DI int crow(int r, int hi) { return (r & 3) + 8 * (r >> 2) + 4 * hi; }
typedef short v4i16_t __attribute__((ext_vector_type(4)));
DI s16x4 trread(lptr p) { return __builtin_bit_cast(s16x4, __builtin_amdgcn_ds_read_tr16_b64_v4i16((LAS v4i16_t*)p)); }
DI bf16x8 trfrag(lptr plo, lptr phi) { const s16x4 a = trread(plo), b = trread(phi); return __builtin_shufflevector(a, b, 0, 1, 2, 3, 4, 5, 6, 7); }
DI int tr_off(int lane, int rs) { const int i = lane & 15; return (i >> 2) * rs + (((lane >> 4) & 1) * 16 + (i & 3) * 4) * 2; }

struct Args { const float* in[20]; float* out; unsigned char* ws; int ph_lo, ph_hi; };

struct TrItem { const float* src; bf16_t* dst; int K, N; };
DI TrItem p0_decode(const Args& a, int it) {
    constexpr int I_IN = (DM / 64) * (20544 / 64), I_SSM = (DIN / 64) * (DM / 64), I_ATT = (DM / 64) * (DM / 64), I_O = I_ATT, I_UP = (DM / 64) * (NUP / 64);
    const float* W; bf16_t* WT; int K, N, map = 0, r = it; unsigned char* ws = a.ws;
    if (r < I_IN) { W = a.in[2]; WT = (bf16_t*)(ws + WS_WIN); K = DM; N = 20544; map = 1; }
    else if ((r -= I_IN) < I_SSM) { W = a.in[12]; WT = (bf16_t*)(ws + WS_WSSM); K = DIN; N = DM; }
    else if ((r -= I_SSM) < I_ATT) { W = a.in[13]; WT = (bf16_t*)(ws + WS_WATT); K = DM; N = DM; }
    else if ((r -= I_ATT) < I_O) { W = a.in[14]; WT = (bf16_t*)(ws + WS_WO); K = DM; N = DM; }
    else if ((r -= I_O) < I_UP) { W = a.in[16]; WT = (bf16_t*)(ws + WS_WUP); K = DM; N = NUP; map = 2; }
    else { r -= I_UP; W = a.in[19]; WT = (bf16_t*)(ws + WS_WDN); K = FFN; N = DM; }
    const int nblk = N / 64, kb = r / nblk, nb = r % nblk, k0 = 64 * kb, n0 = 64 * nb;
    int d0 = n0;
    if (map == 1) { if (n0 >= 10304) d0 = n0 - 64; else if (n0 >= 10240) d0 = OFF_DT + (n0 - 10240); }
    if (map == 2) { const int g_ = n0 >= FFN, n1 = n0 - g_ * FFN; d0 = 256 * (n1 >> 7) + 128 * g_ + (n1 & 127); }
    TrItem t; t.src = W + (size_t)k0 * N + n0; t.dst = WT + (size_t)d0 * K + k0; t.K = K; t.N = N; return t;
}
DI void p0_tr_load(f32x4 (&v)[16], const TrItem& t, int lane) {
    const int c = lane & 15, rsub = lane >> 4;
#pragma unroll
    for (int i = 0; i < 16; ++i) v[i] = *(const f32x4*)(t.src + (size_t)(4 * i + rsub) * t.N + 4 * c);
}
DI void p0_tr_store(const f32x4 (&v)[16], const TrItem& t, LAS float* scr, int lane) {
    const int c = lane & 15, rsub = lane >> 4;
#pragma unroll
    for (int i = 0; i < 16; ++i) { LAS float* d = scr + (4 * i + rsub) * 65 + 4 * c; d[0] = v[i].x; d[1] = v[i].y; d[2] = v[i].z; d[3] = v[i].w; }
    asm volatile("s_waitcnt lgkmcnt(0)" ::: "memory");
    const int kc = lane & 7, nsub = lane >> 3;
#pragma unroll
    for (int j = 0; j < 8; ++j) { const int n = nsub + 8 * j; const LAS float* s = scr + (8 * kc) * 65 + n;
        u32x4 o; o.x = pk2(s[0 * 65], s[1 * 65]); o.y = pk2(s[2 * 65], s[3 * 65]); o.z = pk2(s[4 * 65], s[5 * 65]); o.w = pk2(s[6 * 65], s[7 * 65]);
        *(u32x4*)(t.dst + (size_t)n * t.K + 8 * kc) = o; }
    asm volatile("s_waitcnt lgkmcnt(0)" ::: "memory");
}
DI void p0_prologue(const Args& a, lptr lds, int vcu, int G) {
    const int tid = threadIdx.x, lane = tid & 63, wave = tid >> 6;
    unsigned char* ws = a.ws;
    LAS float* scr = (LAS float*)(lds + wave * 16640);
    const int gw = vcu * NWAVES + wave, NGW = G * NWAVES;
    const int gt = blockIdx.x * NTHR + tid, NGT = G * NTHR;
    for (int i = gt; i < MTOK; i += NGT) ((float*)(ws + WS_CTL + CTL_ROWSS))[i] = 0.f;
    constexpr int NITEMS = (DM / 64) * (20544 / 64) + (DIN / 64) * (DM / 64) + 2 * (DM / 64) * (DM / 64) + (DM / 64) * (NUP / 64) + (FFN / 64) * (DM / 64);
    if (gw < NITEMS) {
        f32x4 va[16], vb[16];
        TrItem ta = p0_decode(a, gw), tb = ta;
        p0_tr_load(va, ta, lane);
        for (int it = gw; it < NITEMS; it += 2 * NGW) {
            const bool hb = it + NGW < NITEMS;
            if (hb) { tb = p0_decode(a, it + NGW); p0_tr_load(vb, tb, lane); }
            p0_tr_store(va, ta, scr, lane);
            if (!hb) break;
            const bool ha = it + 2 * NGW < NITEMS;
            if (ha) { ta = p0_decode(a, it + 2 * NGW); p0_tr_load(va, ta, lane); }
            p0_tr_store(vb, tb, scr, lane);
            if (!ha) break;
        }
    }
    const float* x = a.in[0]; const float* nw = a.in[1]; bf16_t* U = (bf16_t*)(ws + WS_U);
    for (int m = gw; m < MTOK; m += NGW) {
        const f32x4* xr = (const f32x4*)(x + (size_t)m * DM) + lane;
        f32x4 v[8]; float s = 0.f;
#pragma unroll
        for (int j = 0; j < 8; ++j) { v[j] = xr[64 * j]; s += (v[j].x * v[j].x + v[j].y * v[j].y) + (v[j].z * v[j].z + v[j].w * v[j].w); }
        const float r = __builtin_amdgcn_rsqf(wave_sum(s) * (1.0f / DM) + EPS);
        unsigned long long* o8 = (unsigned long long*)(U + (size_t)m * DM) + lane;
#pragma unroll
        for (int j = 0; j < 8; ++j) { const f32x4 w = ((const f32x4*)nw)[64 * j + lane];
            o8[64 * j] = (unsigned long long)pk2(v[j].x * r * w.x, v[j].y * r * w.y) | ((unsigned long long)pk2(v[j].z * r * w.z, v[j].w * r * w.w) << 32); }
    }
}

DI void dt_gemm(const Args& a, lptr lds, int vcu, int G) {
    const int tid = threadIdx.x, lane = tid & 63, wid = __builtin_amdgcn_readfirstlane(tid >> 6), r32 = lane & 31, hi = lane >> 5;
    const bf16_t* U = (const bf16_t*)(a.ws + WS_U); const bf16_t* Wd = (const bf16_t*)(a.ws + WS_WIN) + (size_t)OFF_DT * DM;
    float* DT = (float*)(a.ws + WS_DT);
    LAS float* red = (LAS float*)lds;
    for (int rb = vcu; rb < MTOK / 32; rb += G) {
        const int kbase = wid * 256 + 8 * hi;
        f32x16 acc[2];
#pragma unroll
        for (int nb = 0; nb < 2; ++nb)
#pragma unroll
            for (int k = 0; k < 16; ++k) acc[nb][k] = 0.f;
        const bf16_t* ap = U + (size_t)(rb * 32 + r32) * DM + kbase; const bf16_t* bp = Wd + (size_t)r32 * DM + kbase;
#pragma unroll 4
        for (int ks = 0; ks < 16; ++ks) { const bf16x8 af = *(const bf16x8*)(ap + 16 * ks), b0 = *(const bf16x8*)(bp + 16 * ks), b1 = *(const bf16x8*)(bp + (size_t)32 * DM + 16 * ks);
            acc[0] = MFMA32(af, b0, acc[0]); acc[1] = MFMA32(af, b1, acc[1]); }
#pragma unroll
        for (int nb = 0; nb < 2; ++nb)
#pragma unroll
            for (int i = 0; i < 16; ++i) red[(wid * 2 + nb) * 1024 + crow(i, hi) * 32 + r32] = acc[nb][i];
        __syncthreads();
        for (int o = tid; o < 2048; o += NTHR) { const int nb = o >> 10, rem = o & 1023; float sacc = 0.f;
#pragma unroll
            for (int w = 0; w < 8; ++w) sacc += red[(w * 2 + nb) * 1024 + rem];
            DT[(size_t)(rb * 32 + (rem >> 5)) * 64 + nb * 32 + (rem & 31)] = sacc; }
        __syncthreads();
    }
}

template <int NT> DI void conv_load(u32x4 (&raw)[NT + 3], const bf16_t* srow, int seq0, int col, int t0) {
#pragma unroll
    for (int i = 0; i < NT + 3; ++i) { const int t = t0 - 3 + i; const bool ok = (seq0 + t) >= 0; raw[i] = *(const u32x4*)(srow + (ptrdiff_t)(ok ? t : 0) * NPROJ + col); if (!ok) raw[i] = (u32x4){0u, 0u, 0u, 0u}; }
}
template <int NT> DI void conv_compute(const u32x4 (&raw)[NT + 3], int col, const float* cw, const float* cb, int t0, lptr dst, int rs, int dbyte, const LAS float* scale, bf16_t* gdst = nullptr, int gld = 0) {
    const int ch = col - OFF_XBC;
    float w[4][8], bs[8], h0[8], h1[8], h2[8];
#pragma unroll
    for (int k = 0; k < 4; ++k) { const f32x4 a = *(const f32x4*)(cw + (size_t)k * 6144 + ch), b = *(const f32x4*)(cw + (size_t)k * 6144 + ch + 4);
        w[k][0] = a.x; w[k][1] = a.y; w[k][2] = a.z; w[k][3] = a.w; w[k][4] = b.x; w[k][5] = b.y; w[k][6] = b.z; w[k][7] = b.w; }
    { const f32x4 a = *(const f32x4*)(cb + ch), b = *(const f32x4*)(cb + ch + 4); bs[0] = a.x; bs[1] = a.y; bs[2] = a.z; bs[3] = a.w; bs[4] = b.x; bs[5] = b.y; bs[6] = b.z; bs[7] = b.w; }
#define CV_UNPACK(dstv, r_) do { dstv[0] = bflo(r_.x); dstv[1] = bfhi(r_.x); dstv[2] = bflo(r_.y); dstv[3] = bfhi(r_.y); dstv[4] = bflo(r_.z); dstv[5] = bfhi(r_.z); dstv[6] = bflo(r_.w); dstv[7] = bfhi(r_.w); } while (0)
    CV_UNPACK(h0, raw[0]); CV_UNPACK(h1, raw[1]); CV_UNPACK(h2, raw[2]);
#pragma unroll
    for (int tt = 0; tt < NT; ++tt) {
        float cur[8], y[8]; CV_UNPACK(cur, raw[3 + tt]);
        const float sc = scale ? scale[t0 + tt] : 1.0f;
#pragma unroll
        for (int j = 0; j < 8; ++j) { const float v = bs[j] + w[0][j] * h0[j] + w[1][j] * h1[j] + w[2][j] * h2[j] + w[3][j] * cur[j]; y[j] = siluf_(v); h0[j] = h1[j]; h1[j] = h2[j]; h2[j] = cur[j]; }
        if (gdst) { u32x4 og; og.x = pk2(y[0], y[1]); og.y = pk2(y[2], y[3]); og.z = pk2(y[4], y[5]); og.w = pk2(y[6], y[7]); *(u32x4*)(gdst + (size_t)tt * gld) = og; }
        u32x4 o; o.x = pk2(y[0] * sc, y[1] * sc); o.y = pk2(y[2] * sc, y[3] * sc); o.z = pk2(y[4] * sc, y[5] * sc); o.w = pk2(y[6] * sc, y[7] * sc);
        *(LAS u32x4*)(dst + (t0 + tt) * rs + dbyte) = o;
    }
#undef CV_UNPACK
}

DI void ssd_dt(const Args& a, const float* dtrow, int g, LAS float* dtv, LAS float* acs, float* cd_out) {
    const int lane = threadIdx.x & 63, e = threadIdx.x >> 6, head = g * 8 + e;
    const float bias = a.in[5][head], A = -__expf(a.in[6][head]);
    const float d0 = softplusf_(dtrow[(2 * lane) * 64 + head] + bias), d1 = softplusf_(dtrow[(2 * lane + 1) * 64 + head] + bias);
    const float a0 = d0 * A, a1 = d1 * A; float inc = a0 + a1;
#pragma unroll
    for (int o = 1; o < 64; o <<= 1) { const float t = __shfl_up(inc, o); if (lane >= o) inc += t; }
    dtv[e * 128 + 2 * lane] = d0; dtv[e * 128 + 2 * lane + 1] = d1;
    acs[e * 128 + 2 * lane] = inc - a1; acs[e * 128 + 2 * lane + 1] = inc;
    if (cd_out && lane == 63) cd_out[head] = __expf(inc);
}

DI void ssd_states_unit(const Args& a, lptr lds, int b, int c, int g) {
    int tid_ = threadIdx.x; asm volatile("" : "+v"(tid_));
    const int tid = tid_, lane = tid & 63, wid = __builtin_amdgcn_readfirstlane(tid >> 6), r32 = lane & 31, hi = lane >> 5;
    const bf16_t* proj = (const bf16_t*)(a.ws + WS_PROJ);
    const bf16_t* srow = proj + (size_t)(b * SEQ + c * 128) * NPROJ;
    const int seq0 = c * 128;
    constexpr int RSB = 288, RSX = 544;
    lptr Bn = lds, Xn = lds + 128 * RSB; LAS float* dtv = (LAS float*)(lds + 128 * RSB + 128 * RSX); LAS float* acs = dtv + 1024; LAS float* wsc = acs + 1024;
    float* cd = (float*)(a.ws + WS_CTL + CTL_CD) + (size_t)(b * 32 + c) * 64;
    const int bcol = OFF_XBC + DIN + g * 128 + (tid & 15) * 8, xcc = tid & 31, xtg = tid >> 5;
    u32x4 rawB[11], rawX[11];
    if (tid < 256) conv_load<8>(rawB, srow, seq0, bcol, (tid >> 4) * 8);
    conv_load<8>(rawX, srow, seq0, OFF_XBC + g * 512 + xcc * 8, xtg * 8);
    ssd_dt(a, (const float*)(a.ws + WS_DT) + (size_t)(b * SEQ + c * 128) * 64, g, dtv, acs, cd);
    __syncthreads();
    for (int i = tid; i < 1024; i += NTHR) { const int e = i >> 7; wsc[i] = dtv[i] * __expf(acs[e * 128 + 127] - acs[i]); }
    const size_t grow0 = (size_t)b * SEQ + c * 128;
    if (tid < 256) conv_compute<8>(rawB, bcol, a.in[3], a.in[4], (tid >> 4) * 8, Bn, RSB, (tid & 15) * 16, nullptr, (bf16_t*)a.out + (grow0 + (tid >> 4) * 8) * 1024 + g * 128 + (tid & 15) * 8, 1024);
    bf16_t* ST = (bf16_t*)(a.ws + WS_ST) + (size_t)((b * 32 + c) * 64 + g * 8) * 8192;
    const int tro_b = tr_off(lane, RSB), tro_x = tr_off(lane, RSX);
    for (int r = 0; r < 2; ++r) {
        __syncthreads();
        conv_compute<8>(rawX, OFF_XBC + g * 512 + r * 256 + xcc * 8, a.in[3], a.in[4], xtg * 8, Xn, RSX, xcc * 16, wsc + (r * 4 + (xcc >> 3)) * 128, (bf16_t*)(a.ws + WS_Y) + (grow0 + xtg * 8) * DIN + g * 512 + r * 256 + xcc * 8, DIN);
        __syncthreads();
        if (r == 0) conv_load<8>(rawX, srow, seq0, OFF_XBC + g * 512 + 256 + xcc * 8, xtg * 8);
        const int hl = wid >> 1, nh = wid & 1;
        f32x16 acc[2][2];
#pragma unroll
        for (int i = 0; i < 2; ++i)
#pragma unroll
            for (int j = 0; j < 2; ++j)
#pragma unroll
                for (int k = 0; k < 16; ++k) acc[i][j][k] = 0.f;
#pragma unroll 2
        for (int ks = 0; ks < 8; ++ks) {
            const int krow = 16 * ks + 8 * hi;
            bf16x8 af[2], bfr[2];
#pragma unroll
            for (int pb = 0; pb < 2; ++pb) { lptr p = Xn + krow * RSX + (hl * 64 + 32 * pb) * 2 + tro_x; af[pb] = trfrag(p, p + 4 * RSX); }
#pragma unroll
            for (int nb = 0; nb < 2; ++nb) { lptr p = Bn + krow * RSB + (64 * nh + 32 * nb) * 2 + tro_b; bfr[nb] = trfrag(p, p + 4 * RSB); }
#pragma unroll
            for (int pb = 0; pb < 2; ++pb)
#pragma unroll
                for (int nb = 0; nb < 2; ++nb) acc[pb][nb] = MFMA32(bfr[nb], af[pb], acc[pb][nb]);
        }
        bf16_t* dst = ST + (size_t)(r * 4 + hl) * 8192;
#pragma unroll
        for (int pb = 0; pb < 2; ++pb)
#pragma unroll
            for (int nb = 0; nb < 2; ++nb)
#pragma unroll
                for (int gq = 0; gq < 4; ++gq) { const unsigned long long w = (unsigned long long)pk2(acc[pb][nb][4 * gq], acc[pb][nb][4 * gq + 1]) | ((unsigned long long)pk2(acc[pb][nb][4 * gq + 2], acc[pb][nb][4 * gq + 3]) << 32);
                    *(unsigned long long*)(dst + (32 * pb + r32) * 128 + 64 * nh + 32 * nb + 8 * gq + 4 * hi) = w; }
    }
    __syncthreads();
}

DI void attn_unit(const Args& a, lptr lds, int b, int h, int qb) {
    int tid_ = threadIdx.x; asm volatile("" : "+v"(tid_));
    const int tid = tid_, lane = tid & 63, wid = __builtin_amdgcn_readfirstlane(tid >> 6), r32 = lane & 31, hi = lane >> 5;
    const bf16_t* proj = (const bf16_t*)(a.ws + WS_PROJ);
    bf16_t* att = (bf16_t*)(a.ws + WS_U);
    const size_t rowbase = (size_t)b * SEQ; const int q0 = qb * 256;
    constexpr int RSK = 272, RSV = 288;
    lptr Qs = lds, Ks = lds, Vs = lds + 64 * RSK;
    const int dc = tid & 15, rsub = tid >> 4;
    float wn[8];
    { const f32x4 w0 = *(const f32x4*)(a.in[9] + dc * 8), w1 = *(const f32x4*)(a.in[9] + dc * 8 + 4); const float sc = 0.08838834764831845f * 1.4426950408889634f;
      wn[0] = w0.x * sc; wn[1] = w0.y * sc; wn[2] = w0.z * sc; wn[3] = w0.w * sc; wn[4] = w1.x * sc; wn[5] = w1.y * sc; wn[6] = w1.z * sc; wn[7] = w1.w * sc; }
#pragma unroll 2
    for (int i = 0; i < 8; ++i) { const int row = rsub + 32 * i;
        const u32x4 r_ = *(const u32x4*)(proj + (rowbase + q0 + row) * NPROJ + OFF_Q + h * 128 + dc * 8);
        float f[8] = {bflo(r_.x), bfhi(r_.x), bflo(r_.y), bfhi(r_.y), bflo(r_.z), bfhi(r_.z), bflo(r_.w), bfhi(r_.w)};
        float ss = 0.f;
#pragma unroll
        for (int j = 0; j < 8; ++j) ss += f[j] * f[j];
        ss += __shfl_xor(ss, 1); ss += __shfl_xor(ss, 2); ss += __shfl_xor(ss, 4); ss += __shfl_xor(ss, 8);
        const float rn = __builtin_amdgcn_rsqf(ss * (1.0f / 128.0f) + EPS);
        u32x4 o; o.x = pk2(f[0] * rn * wn[0], f[1] * rn * wn[1]); o.y = pk2(f[2] * rn * wn[2], f[3] * rn * wn[3]); o.z = pk2(f[4] * rn * wn[4], f[5] * rn * wn[5]); o.w = pk2(f[6] * rn * wn[6], f[7] * rn * wn[7]);
        *(LAS u32x4*)(Qs + row * RSK + dc * 16) = o; }
    __syncthreads();
    bf16x8 qf[8];
#pragma unroll
    for (int ds = 0; ds < 8; ++ds) qf[ds] = *(const LAS bf16x8*)(Qs + (wid * 32 + r32) * RSK + (16 * ds + 8 * hi) * 2);
    __syncthreads();
    { const f32x4 w0 = *(const f32x4*)(a.in[10] + dc * 8), w1 = *(const f32x4*)(a.in[10] + dc * 8 + 4);
      wn[0] = w0.x; wn[1] = w0.y; wn[2] = w0.z; wn[3] = w0.w; wn[4] = w1.x; wn[5] = w1.y; wn[6] = w1.z; wn[7] = w1.w; }
    f32x16 o[4];
#pragma unroll
    for (int d0 = 0; d0 < 4; ++d0)
#pragma unroll
        for (int k = 0; k < 16; ++k) o[d0][k] = 0.f;
    float R = 0.f;
    LAS int* flags = (LAS int*)(lds + 256 * RSK);
    if (lane == 0) flags[wid] = 0;
    bool mydone = false;
    const int qw0 = q0 + wid * 32, qpos = qw0 + r32;
    const int ntiles = (q0 + 256) / 64;
    const bf16_t* kvbase = proj + rowbase * NPROJ + h * 128 + dc * 8;
    u32x4 kreg[2], vreg[2];
#define AT_PREFETCH(kt) do { _Pragma("unroll") for (int i_ = 0; i_ < 2; ++i_) { const bf16_t* p_ = kvbase + (size_t)((kt) * 64 + rsub + 32 * i_) * NPROJ; \
        kreg[i_] = *(const u32x4*)(p_ + OFF_K); vreg[i_] = *(const u32x4*)(p_ + OFF_V); } } while (0)
    AT_PREFETCH(ntiles - 1);
    const int tro_v = tr_off(lane, RSV);
    for (int kt = ntiles - 1; kt >= 0; --kt) {
#pragma unroll
        for (int i = 0; i < 2; ++i) { const int key = rsub + 32 * i; const u32x4 r_ = kreg[i];
            float f[8] = {bflo(r_.x), bfhi(r_.x), bflo(r_.y), bfhi(r_.y), bflo(r_.z), bfhi(r_.z), bflo(r_.w), bfhi(r_.w)};
            float ss = 0.f;
#pragma unroll
            for (int j = 0; j < 8; ++j) ss += f[j] * f[j];
            ss += __shfl_xor(ss, 1); ss += __shfl_xor(ss, 2); ss += __shfl_xor(ss, 4); ss += __shfl_xor(ss, 8);
            const float rn = __builtin_amdgcn_rsqf(ss * (1.0f / 128.0f) + EPS);
            u32x4 w; w.x = pk2(f[0] * rn * wn[0], f[1] * rn * wn[1]); w.y = pk2(f[2] * rn * wn[2], f[3] * rn * wn[3]); w.z = pk2(f[4] * rn * wn[4], f[5] * rn * wn[5]); w.w = pk2(f[6] * rn * wn[6], f[7] * rn * wn[7]);
            *(LAS u32x4*)(Ks + key * RSK + dc * 16) = w;
            *(LAS u32x4*)(Vs + key * RSV + dc * 16) = vreg[i]; }
        __syncthreads();
        if (kt > 0) AT_PREFETCH(kt - 1);
        const int key0 = kt * 64;
        if (!mydone && key0 < qw0 + 31) {
#pragma unroll
            for (int blk = 1; blk >= 0; --blk) {
                const int kb0 = key0 + 32 * blk;
                if (kb0 < qw0 + 31) {
                    f32x16 z;
#pragma unroll
                    for (int k = 0; k < 16; ++k) z[k] = 0.f;
#pragma unroll
                    for (int ds = 0; ds < 8; ++ds) { const bf16x8 kf = *(const LAS bf16x8*)(Ks + (32 * blk + r32) * RSK + (16 * ds + 8 * hi) * 2); z = MFMA32(kf, qf[ds], z); }
                    float lk[16], lb[16];
#pragma unroll
                    for (int i = 0; i < 16; ++i) { const float zz = z[i]; const float l1p = __builtin_amdgcn_logf(1.0f + __builtin_amdgcn_exp2f(-fabsf(zz)));
                        const float lbv = fminf(zz, 0.f) - l1p, lkv = lbv - zz; const bool valid = (kb0 + crow(i, hi)) < qpos;
                        lk[i] = valid ? lkv : 0.f; lb[i] = valid ? lbv : -INFINITY; }
                    float suf[16], gs[4], pgs[4], aft[4];
#pragma unroll
                    for (int j = 0; j < 4; ++j) { suf[4 * j + 3] = 0.f; suf[4 * j + 2] = lk[4 * j + 3]; suf[4 * j + 1] = suf[4 * j + 2] + lk[4 * j + 2]; suf[4 * j] = suf[4 * j + 1] + lk[4 * j + 1]; gs[j] = suf[4 * j] + lk[4 * j]; }
#pragma unroll
                    for (int j = 0; j < 4; ++j) pgs[j] = __shfl_xor(gs[j], 32);
                    const float T0 = gs[0] + pgs[0], T1 = gs[1] + pgs[1], T2 = gs[2] + pgs[2], T3 = gs[3] + pgs[3];
                    const float SP2 = T3, SP1 = SP2 + T2, SP0 = SP1 + T1, total = SP0 + T0;
                    aft[3] = 0.f; aft[2] = SP2; aft[1] = SP1; aft[0] = SP0;
                    if (hi == 0) {
#pragma unroll
                        for (int j = 0; j < 4; ++j) aft[j] += pgs[j]; }
                    float p[16];
#pragma unroll
                    for (int i = 0; i < 16; ++i) p[i] = __builtin_amdgcn_exp2f(lb[i] + (R + aft[i >> 2] + suf[i]));
                    R += total;
                    bf16x8 pa[2];
#pragma unroll
                    for (int s = 0; s < 2; ++s) { u32x4 w; w.x = pk2(p[8 * s], p[8 * s + 1]); w.y = pk2(p[8 * s + 2], p[8 * s + 3]); w.z = pk2(p[8 * s + 4], p[8 * s + 5]); w.w = pk2(p[8 * s + 6], p[8 * s + 7]); pa[s] = __builtin_bit_cast(bf16x8, w); }
#pragma unroll
                    for (int s = 0; s < 2; ++s)
#pragma unroll
                        for (int d0 = 0; d0 < 4; ++d0) { lptr vp = Vs + (32 * blk + 16 * s + 4 * hi) * RSV + (32 * d0) * 2 + tro_v; const bf16x8 vf = trfrag(vp, vp + 8 * RSV); o[d0] = MFMA32(vf, pa[s], o[d0]); }
                }
            }
            mydone = __all(R < -150.1f);
            if (mydone && lane == 0) flags[wid] = 1;
        }
        __syncthreads();
        { int alld = 1;
#pragma unroll
          for (int w = 0; w < 8; ++w) alld &= flags[w];
          if (alld) break; }
    }
    __syncthreads();
#undef AT_PREFETCH
    bf16_t* orow = att + (rowbase + qw0 + r32) * DM + h * 128 + 4 * hi;
#pragma unroll
    for (int d0 = 0; d0 < 4; ++d0)
#pragma unroll
        for (int gq = 0; gq < 4; ++gq) { const unsigned long long w = (unsigned long long)pk2(o[d0][4 * gq], o[d0][4 * gq + 1]) | ((unsigned long long)pk2(o[d0][4 * gq + 2], o[d0][4 * gq + 3]) << 32);
            *(unsigned long long*)(orow + 32 * d0 + 8 * gq) = w; }
}

DI void ssd_scan(const Args& a) {
    bf16_t* ST = (bf16_t*)(a.ws + WS_ST); const float* cd = (const float*)(a.ws + WS_CTL + CTL_CD);
    const int NIT = BATCH * 64 * 8192 / 8;
    for (int it = blockIdx.x * NTHR + threadIdx.x; it < NIT; it += gridDim.x * NTHR) {
        const int b = it / (64 * 1024), rem = it % (64 * 1024), head = rem / 1024;
        float run[8];
#pragma unroll
        for (int j = 0; j < 8; ++j) run[j] = 0.f;
        u32x4* p = (u32x4*)(ST + (size_t)b * 32 * 64 * 8192 + (size_t)rem * 8);
        for (int c = 0; c < 32; ++c) {
            const u32x4 v = p[(size_t)c * (64 * 8192 / 8)]; const float d = cd[(b * 32 + c) * 64 + head];
            u32x4 o; o.x = pk2(run[0], run[1]); o.y = pk2(run[2], run[3]); o.z = pk2(run[4], run[5]); o.w = pk2(run[6], run[7]);
            p[(size_t)c * (64 * 8192 / 8)] = o;
            run[0] = run[0] * d + bflo(v.x); run[1] = run[1] * d + bfhi(v.x); run[2] = run[2] * d + bflo(v.y); run[3] = run[3] * d + bfhi(v.y);
            run[4] = run[4] * d + bflo(v.z); run[5] = run[5] * d + bfhi(v.z); run[6] = run[6] * d + bflo(v.w); run[7] = run[7] * d + bfhi(v.w);
        }
    }
}

DI void ssd_out_unit(const Args& a, lptr lds, int b, int c, int g) {
    int tid_ = threadIdx.x; asm volatile("" : "+v"(tid_));
    const int tid = tid_, lane = tid & 63, wid = __builtin_amdgcn_readfirstlane(tid >> 6), r32 = lane & 31, hi = lane >> 5;
    const bf16_t* proj = (const bf16_t*)(a.ws + WS_PROJ);
    const size_t row0 = (size_t)b * SEQ + c * 128;
    const bf16_t* srow = proj + row0 * NPROJ;
    const int seq0 = c * 128;
    constexpr int RSC = 272, RSX = 544;
    lptr Cn = lds, CBh = lds + 128 * RSC, Bn = CBh + 128 * RSC, Xn = Bn; LAS float* dtv = (LAS float*)(Bn + 128 * RSX); LAS float* acs = dtv + 1024;
    bf16_t* Y = (bf16_t*)(a.ws + WS_Y);
    const int cbcol = OFF_XBC + DIN + (tid < 256 ? 1024 : 0) + g * 128 + (tid & 15) * 8, cbt0 = ((tid & 255) >> 4) * 8;
    const int xcol = OFF_XBC + g * 512 + (tid & 31) * 8, xt0 = (tid >> 5) * 8;
    u32x4 rawCB[11], rawX[8];
    const bf16_t* xsrc = Y + (row0 + xt0) * DIN + g * 512 + (tid & 31) * 8;
    if (tid < 256) conv_load<8>(rawCB, srow, seq0, cbcol, cbt0);
    else {
#pragma unroll
        for (int i = 0; i < 8; ++i) rawCB[i] = *(const u32x4*)((const bf16_t*)a.out + (row0 + cbt0 + i) * 1024 + g * 128 + (tid & 15) * 8); }
#pragma unroll
    for (int i = 0; i < 8; ++i) rawX[i] = *(const u32x4*)(xsrc + (size_t)i * DIN);
    ssd_dt(a, (const float*)(a.ws + WS_DT) + row0 * 64, g, dtv, acs, nullptr);
    if (tid < 256) conv_compute<8>(rawCB, cbcol, a.in[3], a.in[4], cbt0, Cn, RSC, (tid & 15) * 16, nullptr);
    else {
#pragma unroll
        for (int i = 0; i < 8; ++i) *(LAS u32x4*)(Bn + (cbt0 + i) * RSC + (tid & 15) * 16) = rawCB[i]; }
    __syncthreads();
    { const int qbk = wid >> 1;
#pragma unroll
      for (int sbi = 0; sbi < 2; ++sbi) { const int sb = 2 * (wid & 1) + sbi;
        if (sb <= qbk) {
            f32x16 acc;
#pragma unroll
            for (int k = 0; k < 16; ++k) acc[k] = 0.f;
#pragma unroll
            for (int ks = 0; ks < 8; ++ks) { const bf16x8 af = *(const LAS bf16x8*)(Cn + (32 * qbk + r32) * RSC + (16 * ks + 8 * hi) * 2), bf_ = *(const LAS bf16x8*)(Bn + (32 * sb + r32) * RSC + (16 * ks + 8 * hi) * 2);
                acc = MFMA32(af, bf_, acc); }
#pragma unroll
            for (int i = 0; i < 16; ++i) *(LAS bf16_t*)(CBh + (32 * qbk + crow(i, hi)) * RSC + (32 * sb + r32) * 2) = (bf16_t)(pk2(acc[i], 0.f) & 0xffffu);
        } } }
    const int tro_x = tr_off(lane, RSX);
    const bf16_t* PV = (const bf16_t*)(a.ws + WS_ST) + (size_t)((b * 32 + c) * 64 + g * 8) * 8192;
    for (int r = 0; r < 2; ++r) {
        const int hl = wid >> 1, e = 4 * r + hl, head = g * 8 + e, qp = wid & 1;
        __syncthreads();
        const bf16_t* pv = PV + (size_t)e * 8192;
        bf16x8 pvf[8][2];
#pragma unroll
        for (int ks = 0; ks < 8; ++ks)
#pragma unroll
            for (int pb = 0; pb < 2; ++pb) pvf[ks][pb] = *(const bf16x8*)(pv + (32 * pb + r32) * 128 + 16 * ks + 8 * hi);
#pragma unroll
        for (int i = 0; i < 8; ++i) *(LAS u32x4*)(Xn + (xt0 + i) * RSX + (tid & 31) * 16) = rawX[i];
        __syncthreads();
        if (r == 0) {
#pragma unroll
            for (int i = 0; i < 8; ++i) rawX[i] = *(const u32x4*)(xsrc + (size_t)i * DIN + 256); }
        const float dsk = a.in[7][head];
#pragma unroll 1
        for (int qs = 0; qs < 2; ++qs) {
            const int qbk = 2 * qp + qs, q = 32 * qbk + r32;
            f32x16 acc[2];
#pragma unroll
            for (int pb = 0; pb < 2; ++pb)
#pragma unroll
                for (int k = 0; k < 16; ++k) acc[pb][k] = 0.f;
#pragma unroll
            for (int ks = 0; ks < 8; ++ks) { const bf16x8 af = *(const LAS bf16x8*)(Cn + q * RSC + (16 * ks + 8 * hi) * 2);
#pragma unroll
                for (int pb = 0; pb < 2; ++pb) acc[pb] = MFMA32(pvf[ks][pb], af, acc[pb]); }
            const float aq = acs[e * 128 + q];
            { const float sc = __expf(aq);
#pragma unroll
              for (int i = 0; i < 16; ++i) { acc[0][i] *= sc; acc[1][i] *= sc; } }
            for (int ks = 0; ks <= 2 * qbk + 1; ++ks) {
                const int s0 = 16 * ks + 8 * hi;
                const u32x4 cw_ = *(const LAS u32x4*)(CBh + q * RSC + s0 * 2);
                const f32x4 a0 = *(const LAS f32x4*)(acs + e * 128 + s0), a1 = *(const LAS f32x4*)(acs + e * 128 + s0 + 4);
                const f32x4 d0 = *(const LAS f32x4*)(dtv + e * 128 + s0), d1 = *(const LAS f32x4*)(dtv + e * 128 + s0 + 4);
                const float cv[8] = {bflo(cw_.x), bfhi(cw_.x), bflo(cw_.y), bfhi(cw_.y), bflo(cw_.z), bfhi(cw_.z), bflo(cw_.w), bfhi(cw_.w)};
                float m[8];
#pragma unroll
                for (int j = 0; j < 4; ++j) { m[j] = (s0 + j <= q) ? cv[j] * __expf(aq - a0[j]) * d0[j] : 0.f; m[4 + j] = (s0 + 4 + j <= q) ? cv[4 + j] * __expf(aq - a1[j]) * d1[j] : 0.f; }
                u32x4 w; w.x = pk2(m[0], m[1]); w.y = pk2(m[2], m[3]); w.z = pk2(m[4], m[5]); w.w = pk2(m[6], m[7]);
                const bf16x8 af = __builtin_bit_cast(bf16x8, w);
#pragma unroll
                for (int pb = 0; pb < 2; ++pb) { lptr p = Xn + (16 * ks + 8 * hi) * RSX + (hl * 64 + 32 * pb) * 2 + tro_x; const bf16x8 xf = trfrag(p, p + 4 * RSX); acc[pb] = MFMA32(xf, af, acc[pb]); }
            }
#pragma unroll
            for (int pb = 0; pb < 2; ++pb)
#pragma unroll
                for (int gq = 0; gq < 4; ++gq) { const int pc = hl * 64 + 32 * pb + 8 * gq + 4 * hi;
                    const unsigned long long xw = *(const LAS unsigned long long*)(Xn + q * RSX + pc * 2);
                    const float y0 = acc[pb][4 * gq] + dsk * bflo((unsigned)xw), y1 = acc[pb][4 * gq + 1] + dsk * bfhi((unsigned)xw), y2 = acc[pb][4 * gq + 2] + dsk * bflo((unsigned)(xw >> 32)), y3 = acc[pb][4 * gq + 3] + dsk * bfhi((unsigned)(xw >> 32));
                    *(unsigned long long*)(Y + (row0 + q) * DIN + g * 512 + r * 256 + pc) = (unsigned long long)pk2(y0, y1) | ((unsigned long long)pk2(y2, y3) << 32); }
        }
    }
    __builtin_amdgcn_fence(__ATOMIC_RELEASE, "workgroup");
    __syncthreads();
    __builtin_amdgcn_fence(__ATOMIC_ACQUIRE, "workgroup");
    { const float* nw = a.in[8] + g * 512 + lane * 8; const f32x4 w0 = *(const f32x4*)nw, w1 = *(const f32x4*)(nw + 4);
      for (int t4 = wid * 16; t4 < wid * 16 + 16; t4 += 4) {
        u32x4 yv[4], zv[4];
#pragma unroll
        for (int k = 0; k < 4; ++k) { yv[k] = *(const u32x4*)(Y + (row0 + t4 + k) * DIN + g * 512 + lane * 8); zv[k] = *(const u32x4*)(srow + (size_t)(t4 + k) * NPROJ + OFF_Z + g * 512 + lane * 8); }
#pragma unroll
        for (int k = 0; k < 4; ++k) {
            float f[8] = {bflo(yv[k].x), bfhi(yv[k].x), bflo(yv[k].y), bfhi(yv[k].y), bflo(yv[k].z), bfhi(yv[k].z), bflo(yv[k].w), bfhi(yv[k].w)};
            const float zz[8] = {bflo(zv[k].x), bfhi(zv[k].x), bflo(zv[k].y), bfhi(zv[k].y), bflo(zv[k].z), bfhi(zv[k].z), bflo(zv[k].w), bfhi(zv[k].w)};
            float ss = 0.f;
#pragma unroll
            for (int j = 0; j < 8; ++j) { f[j] *= siluf_(zz[j]); ss += f[j] * f[j]; }
            const float rn = __builtin_amdgcn_rsqf(wave_sum(ss) * (1.0f / 512.0f) + EPS);
            u32x4 o; o.x = pk2(f[0] * rn * w0.x, f[1] * rn * w0.y); o.y = pk2(f[2] * rn * w0.z, f[3] * rn * w0.w); o.z = pk2(f[4] * rn * w1.x, f[5] * rn * w1.y); o.w = pk2(f[6] * rn * w1.z, f[7] * rn * w1.w);
            *(u32x4*)(Y + (row0 + t4 + k) * DIN + g * 512 + lane * 8) = o; }
      } }
    __syncthreads();
}

DI void ffn_fixup(const Args& a) {
    bf16_t* H = (bf16_t*)(a.ws + WS_H);
    const float* SBHA = (const float*)(a.ws + WS_SB); const float* SBHG = (const float*)(a.ws + WS_SB + SB_STRIDE); const float* SBT = (const float*)(a.ws + WS_SB + 2 * SB_STRIDE);
    const float* cw = a.in[17]; const float* cb = a.in[18];
    constexpr int NC4 = FFN / 4, NIT = (MTOK / 64) * 2 * NC4;
    for (int it = blockIdx.x * NTHR + threadIdx.x; it < NIT; it += gridDim.x * NTHR) {
        const int c4 = it % NC4, rr = it / NC4, fr = rr & 1, blk = rr >> 1, col = c4 * 4, row = blk * 64 + fr;
        const bool first = ((blk * 64) & (SEQ - 1)) == 0;
        const f32x4 zero = {0.f, 0.f, 0.f, 0.f};
        const f32x4 av = *(const f32x4*)(SBHA + ((size_t)blk * 2 + fr) * FFN + col), gv = *(const f32x4*)(SBHG + ((size_t)blk * 2 + fr) * FFN + col);
        const f32x4 t0 = first ? zero : *(const f32x4*)(SBT + ((size_t)(blk - 1) * 2 + 0) * FFN + col), t1 = first ? zero : *(const f32x4*)(SBT + ((size_t)(blk - 1) * 2 + 1) * FFN + col);
        const f32x4 h0 = *(const f32x4*)(SBHA + ((size_t)blk * 2 + 0) * FFN + col);
        const f32x4 a1 = fr == 1 ? h0 : t1, a2 = fr == 1 ? t1 : t0;
        const f32x4 w0 = *(const f32x4*)(cw + col), w1 = *(const f32x4*)(cw + FFN + col), w2 = *(const f32x4*)(cw + 2 * FFN + col), bs = *(const f32x4*)(cb + col);
        float hv[4];
#pragma unroll
        for (int k = 0; k < 4; ++k) { const float v = bs[k] + w0[k] * a2[k] + w1[k] * a1[k] + w2[k] * av[k]; hv[k] = siluf_(v) * gv[k]; }
        *(unsigned long long*)(H + (size_t)row * FFN + col) = (unsigned long long)pk2(hv[0], hv[1]) | ((unsigned long long)pk2(hv[2], hv[3]) << 32);
    }
}

typedef __attribute__((address_space(1))) unsigned gu32;
#define XB_TMO      128
#define XB_XCNT(j)  (256  + 64 * (j))
#define XB_XSUB(j)  (1280 + 64 * (j))
#define XB_XGEN(j)  (2304 + 64 * (j))
#define XB_TOP      3328
#define XB_TOPGEN   3392
#define XCD_BAR_WORDS 3456
#define XB_SPIN_CAP (1u << 18)

__device__ __forceinline__ unsigned xb_ld(unsigned* p)              { return __hip_atomic_load(p, __ATOMIC_RELAXED, __HIP_MEMORY_SCOPE_AGENT); }
__device__ __forceinline__ unsigned xb_add(unsigned* p, unsigned v) { return __hip_atomic_fetch_add(p, v, __ATOMIC_RELAXED, __HIP_MEMORY_SCOPE_AGENT); }
__device__ __forceinline__ unsigned xb_xcc_id() { return (unsigned)__builtin_amdgcn_s_getreg((3 << 11) | 20) & 0xFu; }
#define XB_SPIN(cond, bar) do { unsigned _sp = 0; while (cond) { __builtin_amdgcn_s_sleep(1); \
    if ((++_sp & 255u) == 0u) { if (xb_ld(&(bar)[XB_TMO])) break; if (_sp > XB_SPIN_CAP) { atomicAdd(&(bar)[XB_TMO], 1u); break; } } } } while (0)

struct XcdBarrier {
    unsigned* bar; unsigned x;
    volatile LAS unsigned* st;
};

__device__ __forceinline__ XcdBarrier xcd_barrier_post(unsigned* bar, volatile LAS unsigned* st) {
    XcdBarrier b; b.bar = bar; b.x = xb_xcc_id(); b.st = st;
    if (threadIdx.x == 0) (void)xb_add(&bar[XB_XCNT(b.x)], 1u);
    return b;
}
__device__ __forceinline__ void xcd_barrier_complete(unsigned* bar, unsigned x, unsigned& nloc, unsigned& nx) {
    const unsigned G = gridDim.x * gridDim.y * gridDim.z;
    unsigned sum, cnt, mine, sp = 0u;
    for (;;) {
        sum = 0u; cnt = 0u; mine = 0u;
#pragma unroll
        for (unsigned j = 0; j < 16; ++j) { const unsigned c = xb_ld(&bar[XB_XCNT(j)]); sum += c; cnt += (c > 0u) ? 1u : 0u; mine = (j == x) ? c : mine; }
        if (sum == G) break;
        __builtin_amdgcn_s_sleep(1);
        if ((++sp & 255u) == 0u) { if (xb_ld(&bar[XB_TMO])) break; if (sp > XB_SPIN_CAP) { atomicAdd(&bar[XB_TMO], 1u); break; } }
    }
    nloc = mine > 0u ? mine : 1u; nx = cnt > 0u ? cnt : 1u;
}

__device__ __forceinline__ void xcd_barrier(const XcdBarrier& b) {
    asm volatile("s_waitcnt vmcnt(0)" ::: "memory");
    __syncthreads();
    if (threadIdx.x == 0) {
        unsigned* bar = b.bar;
        __builtin_amdgcn_s_waitcnt(0);
        unsigned nloc = b.st[0], nx = b.st[1];
        if (nloc == 0u) { xcd_barrier_complete(bar, b.x, nloc, nx); b.st[0] = nloc; b.st[1] = nx; }
        const unsigned old = xb_add(&bar[XB_XSUB(b.x)], 1u);
        const unsigned gen = old / nloc;
        if (old + 1u == (gen + 1u) * nloc) {
            __builtin_amdgcn_fence(__ATOMIC_RELEASE, "agent");
            asm volatile("s_waitcnt vmcnt(0)" ::: "memory");
            const unsigned og = xb_add(&bar[XB_TOP], 1u);
            const unsigned tg = og / nx;
            if (og + 1u == (tg + 1u) * nx) xb_add(&bar[XB_TOPGEN], 1u);
            else XB_SPIN(xb_ld(&bar[XB_TOPGEN]) == tg, bar);
            __builtin_amdgcn_fence(__ATOMIC_ACQUIRE, "agent");
            xb_add(&bar[XB_XGEN(b.x)], 1u);
            asm volatile("s_waitcnt vmcnt(0)" ::: "memory");
        } else {
            XB_SPIN(xb_ld(&bar[XB_XGEN(b.x)]) == gen, bar);
            __builtin_amdgcn_fence(__ATOMIC_ACQUIRE, "agent");
            asm volatile("s_waitcnt vmcnt(0)" ::: "memory");
        }
    }
    __syncthreads();
}

#ifndef GALIGN
#define GALIGN true
#endif
#ifndef GSP2
#define GSP2 true
#endif
#ifndef PHMASK
#define PHMASK 0x3ff
#endif
#ifndef PHREP
#define PHREP 0
#endif
__global__ void __launch_bounds__(NTHR, 2) mk_fwd(Args args) {
    extern __shared__ __attribute__((aligned(16))) unsigned char lds_raw[];
    lptr lds = (lptr)lds_raw;
    const int G = gridDim.x, bx = blockIdx.x;
    const int vcu = (G % 8 == 0) ? (bx % 8) * (G / 8) + bx / 8 : bx;
    unsigned char* ws = args.ws;
    const int lo = args.ph_lo, hi = args.ph_hi;
    volatile LAS unsigned* bst = (volatile LAS unsigned*)(lds + LDS_BYTES - 16);
    if (threadIdx.x < 4) bst[threadIdx.x] = 0u;
    __syncthreads();
    XcdBarrier bar; bar.bar = (unsigned*)(ws + WS_CTL + CTL_BAR); bar.x = 0; bar.st = bst;
    if (hi - lo > 1) bar = xcd_barrier_post((unsigned*)(ws + WS_CTL + CTL_BAR), bst);
    if (hi < 0) cg::this_grid().sync();
#define IN(k) (((PHMASK >> (k)) & 1) && lo <= (k) && (k) < hi)
#define SEAM(k) do { if (IN(k) && IN((k) + 1)) xcd_barrier(bar); } while (0)
#define REP(k) for (int rp_ = 0; rp_ < ((((PHREP) >> (k)) & 1) ? 2 : 1); ++rp_)
#define REPSYNC() do { if (rp_) xcd_barrier(bar); } while (0)
#ifdef NSYNC
    for (int i_ = 0; i_ < NSYNC; ++i_) xcd_barrier(bar);
#endif
    REP(0) { REPSYNC(); if (IN(0)) { p0_prologue(args, lds, vcu, G); __syncthreads(); } }
    SEAM(0);
#define RUN_P1() do { if (IN(1)) { \
        pg8::Gemm g{(const bf16_t*)(ws + WS_U), (const bf16_t*)(ws + WS_WIN), MTOK, OFF_DT, DM}; pg8::StaticOrder S; S.init(MTOK, OFF_DT, G, bx); \
        pg8::Epi<0> E{(bf16_t*)(ws + WS_PROJ), nullptr, nullptr, nullptr, nullptr, nullptr, NPROJ, 0, 0}; \
        pg8::gemm_phase<pg8::Epi<0>, pg8::StaticOrder, GALIGN, GSP2>(lds, g, S, E); \
        dt_gemm(args, lds, vcu, G); } } while (0)
    RUN_P1();
#if (PHREP >> 1) & 1
    xcd_barrier(bar); RUN_P1();
#endif
    SEAM(1);
    if (IN(2)) {
        REP(10) { REPSYNC(); for (int v = vcu; v < 256; v += G) { const int bh = v >> 3, s = v & 7;
            attn_unit(args, lds, bh >> 4, bh & 15, 15 - s); attn_unit(args, lds, bh >> 4, bh & 15, s); } }
        REP(11) { REPSYNC(); for (int u = vcu; u < 512; u += G) ssd_states_unit(args, lds, u >> 8, (u >> 3) & 31, u & 7); }
    }
    SEAM(2);
    if (IN(3)) ssd_scan(args);
    SEAM(3);
    if (IN(4)) { for (int u = vcu; u < 512; u += G) ssd_out_unit(args, lds, u >> 8, (u >> 3) & 31, u & 7); }
#if (PHREP >> 4) & 1
    xcd_barrier(bar); if (IN(4)) { for (int u = vcu; u < 512; u += G) ssd_out_unit(args, lds, u >> 8, (u >> 3) & 31, u & 7); }
#endif
    SEAM(4);
#define RUN_P5() do { if (IN(5)) { \
        { pg8::Gemm g{(const bf16_t*)(ws + WS_Y), (const bf16_t*)(ws + WS_WSSM), MTOK, DM, DIN}; pg8::StaticOrder S; S.init(MTOK, DM, G, bx); \
          pg8::Epi<1> E{nullptr, args.out, nullptr, (const bf16_t*)(ws + WS_PROJ), args.in[11], nullptr, DM, NPROJ, OFF_G}; \
          pg8::gemm_phase<pg8::Epi<1>, pg8::StaticOrder, GALIGN, GSP2>(lds, g, S, E); } \
        __syncthreads(); \
        { pg8::Gemm g{(const bf16_t*)(ws + WS_U), (const bf16_t*)(ws + WS_WATT), MTOK, DM, DM}; pg8::StaticOrder S; S.init(MTOK, DM, G, bx); \
          pg8::Epi<2> E{(bf16_t*)(ws + WS_MIX), args.out, nullptr, (const bf16_t*)(ws + WS_PROJ), args.in[11] + DM, nullptr, DM, NPROJ, OFF_G + DM}; \
          pg8::gemm_phase<pg8::Epi<2>, pg8::StaticOrder, GALIGN, GSP2>(lds, g, S, E); } } } while (0)
    RUN_P5();
#if (PHREP >> 5) & 1
    xcd_barrier(bar); RUN_P5();
#endif
    SEAM(5);
    if (IN(6)) {
        pg8::Gemm g{(const bf16_t*)(ws + WS_MIX), (const bf16_t*)(ws + WS_WO), MTOK, DM, DM}; pg8::StaticOrder S; S.init(MTOK, DM, G, bx);
        pg8::Epi<3> E{(bf16_t*)(ws + WS_U), args.out, args.in[0], nullptr, args.in[15], (float*)(ws + WS_CTL + CTL_ROWSS), DM, 0, 0};
        pg8::gemm_phase<pg8::Epi<3>, pg8::StaticOrder, GALIGN, GSP2>(lds, g, S, E);
    }
    SEAM(6);
#define RUN_P7() do { if (IN(7)) { \
        pg8::Gemm g{(const bf16_t*)(ws + WS_U), (const bf16_t*)(ws + WS_WUP), MTOK, NUP, DM}; pg8::StaticOrder S; S.init(MTOK, NUP, G, bx); \
        pg8::EpiFfn E{(bf16_t*)(ws + WS_H), (const float*)(ws + WS_CTL + CTL_ROWSS), args.in[17], args.in[18], (float*)(ws + WS_SB), (float*)(ws + WS_SB + SB_STRIDE), (float*)(ws + WS_SB + 2 * SB_STRIDE)}; \
        pg8::gemm_phase<pg8::EpiFfn, pg8::StaticOrder, GALIGN, GSP2>(lds, g, S, E); } } while (0)
    RUN_P7();
#if (PHREP >> 7) & 1
    xcd_barrier(bar); RUN_P7();
#endif
    SEAM(7);
    REP(8) { REPSYNC(); if (IN(8)) ffn_fixup(args); }
    SEAM(8);
    if (IN(9)) {
        pg8::Gemm g{(const bf16_t*)(ws + WS_H), (const bf16_t*)(ws + WS_WDN), MTOK, DM, FFN}; pg8::StaticOrder S; S.init(MTOK, DM, G, bx);
        pg8::Epi<5> E{nullptr, args.out, nullptr, nullptr, nullptr, nullptr, DM, 0, 0};
        pg8::gemm_phase<pg8::Epi<5>, pg8::StaticOrder, GALIGN, GSP2>(lds, g, S, E);
    }
#undef IN
#undef SEAM
}

extern "C" void kernel_launch(void* const* d_in, const int* in_sizes, int n_in, void* d_out, int out_size, void* d_ws, size_t ws_size, hipStream_t stream) {
    static int grid = 0;
    if (grid == 0) {
        if (n_in != 20 || out_size != MTOK * DM || ws_size < WS_END) { fprintf(stderr, "kernel_launch: unexpected shapes (n_in %d out %d ws %zu)\n", n_in, out_size, ws_size); grid = -1; return; }
        int dev = 0, cus = 0, per_cu = 0;
        hipGetDevice(&dev); hipDeviceGetAttribute(&cus, hipDeviceAttributeMultiprocessorCount, dev);
        if (hipFuncSetAttribute((const void*)mk_fwd, hipFuncAttributeMaxDynamicSharedMemorySize, LDS_BYTES) != hipSuccess) { fprintf(stderr, "kernel_launch: hipFuncSetAttribute failed\n"); grid = -1; return; }
        if (hipOccupancyMaxActiveBlocksPerMultiprocessor(&per_cu, (const void*)mk_fwd, NTHR, LDS_BYTES) != hipSuccess || per_cu < 1) { fprintf(stderr, "kernel_launch: occupancy query says %d\n", per_cu); per_cu = 1; }
        (void)hipGetLastError();
        grid = cus * 1;
        fprintf(stderr, "kernel_launch: grid %d (cus %d, per_cu %d)\n", grid, cus, per_cu);
    }
    if (grid < 0) return;
    Args a{};
    for (int i = 0; i < 20; ++i) a.in[i] = (const float*)d_in[i];
    a.out = (float*)d_out; a.ws = (unsigned char*)d_ws;
#if MK_N_LAUNCHES == 1
    if (hipMemsetAsync((char*)d_ws + WS_CTL + CTL_BAR, 0, CTL_BAR_BYTES, stream) != hipSuccess) { fprintf(stderr, "kernel_launch: memset of the barrier words failed\n"); return; }
    a.ph_lo = 0; a.ph_hi = 10;
    void* kargs[] = {&a};
    hipError_t e = hipLaunchCooperativeKernel((const void*)mk_fwd, dim3(grid), dim3(NTHR), kargs, LDS_BYTES, stream);
    if (e != hipSuccess) fprintf(stderr, "kernel_launch: cooperative launch failed: %s\n", hipGetErrorString(e));
#else
    for (int ph = 0; ph < 10; ++ph) { a.ph_lo = ph; a.ph_hi = ph + 1; hipLaunchKernelGGL(mk_fwd, dim3(grid), dim3(NTHR), LDS_BYTES, stream, a); }
#endif
}
```

```cpp
#include <hip/hip_runtime.h>
#include <hip/hip_cooperative_groups.h>
#include <cstdio>
#include <cstdint>
namespace cg = cooperative_groups;
#ifndef MK_N_LAUNCHES
#define MK_N_LAUNCHES 1
#endif
#include <hip/hip_runtime.h>
#include <cstdio>
#include <cstdint>
namespace pg8 {
#define PG8_LAS __attribute__((address_space(3)))
typedef unsigned short bf16_t;
typedef short bf16x8 __attribute__((ext_vector_type(8)));
typedef float f32x4 __attribute__((ext_vector_type(4)));
typedef unsigned u32x4 __attribute__((ext_vector_type(4)));
constexpr int BM = 256, BK = 64, HALF = 128, HTB = HALF * BK * 2  , STAGE_BYTES = 8 * HTB, NXCD = 8, WGM = 8;

__host__ __device__ __forceinline__ int lds_byte(int r, int c) { const int st = (r >> 4) * 2 + (c >> 5), rr = r & 15, cc = c & 31, ob = rr * 64 + cc * 2; return st * 1024 + (ob ^ (((ob >> 9) & 1) << 5)); }
__host__ __device__ __forceinline__ void stage_rc(int b, int& R, int& C) { const int st = b / 1024, sb = b % 1024, swz = sb ^ (((sb >> 9) & 1) << 5); R = (st >> 1) * 16 + swz / 64; C = (st & 1) * 32 + (swz % 64) / 2; }
__host__ __device__ __forceinline__ int perm32(int rho) { const int n = rho >> 4, i = rho & 15; return 8 * (i >> 2) + 4 * n + (i & 3); }

struct Unit { int pm, pn; };
struct Gemm { const bf16_t* A; const bf16_t* Bt; int M, N, K; };

struct StaticOrder {
    int nM, nN, nwg, G, c;
    __host__ __device__ void init(int M, int N, int G_, int c_) { nM = M / BM; nN = N / BM; nwg = nM * nN; G = G_; c = c_; }
    __host__ __device__ bool next(int i, Unit& u) const {
        const long L = (long)i * G + c; if (L >= nwg) return false;
        int wgid = (int)L; { const int q = nwg / NXCD, r = nwg % NXCD, xcd = wgid % NXCD, off = wgid / NXCD; wgid = (xcd < r ? xcd * (q + 1) : r * (q + 1) + (xcd - r) * q) + off; }
        const int nig = WGM * nN, gid = wgid / nig, fm = gid * WGM, gsz = (nM - fm) < WGM ? (nM - fm) : WGM;
        u.pm = fm + ((wgid % nig) % gsz); u.pn = (wgid % nig) / gsz; return true;
    }
    __device__ __forceinline__ void a_ready(const Unit&) const {}
    __device__ __forceinline__ void done(const Unit&) const {}
};

typedef float f32x2 __attribute__((ext_vector_type(2)));
typedef __bf16 bf16x2v __attribute__((ext_vector_type(2)));
__device__ __forceinline__ unsigned cvt_pk_bf16(float lo, float hi) { f32x2 v = {lo, hi}; bf16x2v b = __builtin_convertvector(v, bf16x2v); return __builtin_bit_cast(unsigned, b); }
__device__ __forceinline__ float bflo(unsigned w) { return __uint_as_float(w << 16); }
__device__ __forceinline__ float bfhi(unsigned w) { return __uint_as_float(w & 0xffff0000u); }
__device__ __forceinline__ float sigmoidf_(float v) { return __builtin_amdgcn_rcpf(1.0f + __expf(-v)); }
template <int MODE> struct Epi {
    static constexpr bool PERM = true, AFTER_DRAIN = false;
    bf16_t* O; float* T1; const float* X0; const bf16_t* G; const float* gb; float* rowss; int ldc, ldg, gcol0;
    __device__ __forceinline__ void operator()(const f32x4 (&acc)[2][2][4][2], const Unit& u, int wr, int wc, int fr, int fq) const {
        const int row0 = u.pm * BM + wr * 64 + fr, col0 = u.pn * BM + wc * 32 + 8 * fq;
        f32x4 cb_[2][2];
        if (MODE == 1 || MODE == 2 || MODE == 3) {
#pragma unroll
            for (int bj = 0; bj < 2; ++bj) { cb_[bj][0] = *(const f32x4*)(gb + col0 + bj * HALF); cb_[bj][1] = *(const f32x4*)(gb + col0 + bj * HALF + 4); } }
#pragma unroll
        for (int ai = 0; ai < 2; ++ai) {
            u32x4 pg[4][2], pt[4][2]; f32x4 px[4][2][2]; float prs[4];
#pragma unroll
            for (int m = 0; m < 4; ++m) {
                const int row = row0 + ai * HALF + m * 16;
                if (MODE == 4) prs[m] = rowss[row];
#pragma unroll
                for (int bj = 0; bj < 2; ++bj) { const int col = col0 + bj * HALF; const size_t off = (size_t)row * ldc + col;
                    if (MODE == 1 || MODE == 2) pg[m][bj] = *(const u32x4*)(G + (size_t)row * ldg + gcol0 + col);
                    if (MODE == 2) pt[m][bj] = *(const u32x4*)((const bf16_t*)T1 + off);
                    if (MODE == 3) { px[m][bj][0] = *(const f32x4*)(X0 + off); px[m][bj][1] = *(const f32x4*)(X0 + off + 4); }
                    if (MODE == 5) { px[m][bj][0] = *(const f32x4*)(T1 + off); px[m][bj][1] = *(const f32x4*)(T1 + off + 4); } }
            }
#pragma unroll
            for (int m = 0; m < 4; ++m) {
                const int row = row0 + ai * HALF + m * 16;
                float rs = 1.f, ssq = 0.f;
                if (MODE == 4) rs = __builtin_amdgcn_rsqf(prs[m] * (1.0f / 2048.0f) + 1e-6f);
#pragma unroll
                for (int bj = 0; bj < 2; ++bj) {
                    const int col = col0 + bj * HALF; const size_t off = (size_t)row * ldc + col;
                    f32x4 v0 = acc[ai][bj][m][0], v1 = acc[ai][bj][m][1];
                    if (MODE == 1 || MODE == 2) {
                        const u32x4 gw = pg[m][bj]; const f32x4 b0 = cb_[bj][0], b1 = cb_[bj][1];
                        f32x4 s0, s1;
                        s0[0] = sigmoidf_(bflo(gw[0]) + b0[0]); s0[1] = sigmoidf_(bfhi(gw[0]) + b0[1]); s0[2] = sigmoidf_(bflo(gw[1]) + b0[2]); s0[3] = sigmoidf_(bfhi(gw[1]) + b0[3]);
                        s1[0] = sigmoidf_(bflo(gw[2]) + b1[0]); s1[1] = sigmoidf_(bfhi(gw[2]) + b1[1]); s1[2] = sigmoidf_(bflo(gw[3]) + b1[2]); s1[3] = sigmoidf_(bfhi(gw[3]) + b1[3]);
                        v0 = v0 * s0; v1 = v1 * s1;
                        if (MODE == 1) { u32x4 w; w.x = cvt_pk_bf16(v0[0], v0[1]); w.y = cvt_pk_bf16(v0[2], v0[3]); w.z = cvt_pk_bf16(v1[0], v1[1]); w.w = cvt_pk_bf16(v1[2], v1[3]); *(u32x4*)((bf16_t*)T1 + off) = w; }
                        else { const u32x4 t = pt[m][bj];
                            v0[0] += bflo(t.x); v0[1] += bfhi(t.x); v0[2] += bflo(t.y); v0[3] += bfhi(t.y); v1[0] += bflo(t.z); v1[1] += bfhi(t.z); v1[2] += bflo(t.w); v1[3] += bfhi(t.w); }
                    }
                    if (MODE == 3) {
                        v0 = v0 + px[m][bj][0]; v1 = v1 + px[m][bj][1];
                        *(f32x4*)(T1 + off) = v0; *(f32x4*)(T1 + off + 4) = v1;
                        ssq += (v0[0] * v0[0] + v0[1] * v0[1]) + (v0[2] * v0[2] + v0[3] * v0[3]) + (v1[0] * v1[0] + v1[1] * v1[1]) + (v1[2] * v1[2] + v1[3] * v1[3]);
                        v0 = v0 * cb_[bj][0]; v1 = v1 * cb_[bj][1];
                    }
                    if (MODE == 4) { v0 = v0 * rs; v1 = v1 * rs; }
                    if (MODE == 5) {
                        v0 = v0 + px[m][bj][0]; v1 = v1 + px[m][bj][1];
                        *(f32x4*)(T1 + off) = v0; *(f32x4*)(T1 + off + 4) = v1;
                    }
                    if (MODE == 0 || MODE == 2 || MODE == 3 || MODE == 4) {
                        u32x4 w; w.x = cvt_pk_bf16(v0[0], v0[1]); w.y = cvt_pk_bf16(v0[2], v0[3]); w.z = cvt_pk_bf16(v1[0], v1[1]); w.w = cvt_pk_bf16(v1[2], v1[3]);
                        *(u32x4*)(O + off) = w;
                    }
                }
                if (MODE == 3) { ssq += __shfl_xor(ssq, 16); ssq += __shfl_xor(ssq, 32); if (fq == 0) atomicAdd(rowss + row, ssq); }
            }
        }
    }
};

__device__ __forceinline__ float dpp_ror1(float v) { return __builtin_bit_cast(float, __builtin_amdgcn_update_dpp(0, __builtin_bit_cast(int, v), 0x121, 0xf, 0xf, false)); }
__device__ __forceinline__ float dpp_ror2(float v) { return __builtin_bit_cast(float, __builtin_amdgcn_update_dpp(0, __builtin_bit_cast(int, v), 0x122, 0xf, 0xf, false)); }
struct EpiFfn {
    static constexpr bool PERM = true, AFTER_DRAIN = false;
    bf16_t* H; const float* rowss; const float* cw; const float* cb; float* SBHA; float* SBHG; float* SBT;
    __device__ __forceinline__ void operator()(const f32x4 (&acc)[2][2][4][2], const Unit& u, int wr, int wc, int fr, int fq) const {
        constexpr int F = 5632;
        const int j0 = u.pn * HALF + wc * 32 + 8 * fq;
        float w0[8], w1[8], w2[8], bs[8];
#pragma unroll
        for (int h = 0; h < 2; ++h) { const f32x4 a = *(const f32x4*)(cw + j0 + 4 * h), b = *(const f32x4*)(cw + F + j0 + 4 * h), c = *(const f32x4*)(cw + 2 * F + j0 + 4 * h), d = *(const f32x4*)(cb + j0 + 4 * h);
#pragma unroll
            for (int k = 0; k < 4; ++k) { w0[4 * h + k] = a[k]; w1[4 * h + k] = b[k]; w2[4 * h + k] = c[k]; bs[4 * h + k] = d[k]; } }
#pragma unroll
        for (int ai = 0; ai < 2; ++ai) {
            const int R0 = u.pm * BM + ai * HALF + wr * 64, blk = R0 >> 6;
            float ap[8];
#pragma unroll
            for (int k = 0; k < 8; ++k) ap[k] = 0.f;
#pragma unroll
            for (int m = 0; m < 4; ++m) {
                const int row = R0 + 16 * m + fr;
                const float rs = __builtin_amdgcn_rsqf(rowss[row] * (1.0f / 2048.0f) + 1e-6f);
                float av[8], gv[8], hv[8];
#pragma unroll
                for (int k = 0; k < 4; ++k) { av[k] = acc[ai][0][m][0][k] * rs; av[4 + k] = acc[ai][0][m][1][k] * rs; gv[k] = acc[ai][1][m][0][k] * rs; gv[4 + k] = acc[ai][1][m][1][k] * rs; }
#pragma unroll
                for (int k = 0; k < 8; ++k) {
                    const float s1 = dpp_ror1(av[k]), s2 = dpp_ror2(av[k]), p1 = dpp_ror1(ap[k]), p2 = dpp_ror2(ap[k]);
                    const float a1 = fr >= 1 ? s1 : p1, a2 = fr >= 2 ? s2 : p2;
                    const float v = bs[k] + w0[k] * a2 + w1[k] * a1 + w2[k] * av[k];
                    hv[k] = v * __builtin_amdgcn_rcpf(1.0f + __expf(-v)) * gv[k];
                }
                if (m > 0 || fr >= 2) {
                    u32x4 w; w.x = cvt_pk_bf16(hv[0], hv[1]); w.y = cvt_pk_bf16(hv[2], hv[3]); w.z = cvt_pk_bf16(hv[4], hv[5]); w.w = cvt_pk_bf16(hv[6], hv[7]);
                    *(u32x4*)(H + (size_t)row * F + j0) = w;
                } else {
                    const size_t o = ((size_t)blk * 2 + fr) * F + j0;
                    *(f32x4*)(SBHA + o) = (f32x4){av[0], av[1], av[2], av[3]}; *(f32x4*)(SBHA + o + 4) = (f32x4){av[4], av[5], av[6], av[7]};
                    *(f32x4*)(SBHG + o) = (f32x4){gv[0], gv[1], gv[2], gv[3]}; *(f32x4*)(SBHG + o + 4) = (f32x4){gv[4], gv[5], gv[6], gv[7]};
                }
                if (m == 3 && fr >= 14) {
                    const size_t o = ((size_t)blk * 2 + (fr - 14)) * F + j0;
                    *(f32x4*)(SBT + o) = (f32x4){av[0], av[1], av[2], av[3]}; *(f32x4*)(SBT + o + 4) = (f32x4){av[4], av[5], av[6], av[7]};
                }
#pragma unroll
                for (int k = 0; k < 8; ++k) ap[k] = av[k];
            }
        }
    }
};

template <class Epi, class Sched, bool ALIGN_EPI = false, bool SP2 = false>
__device__ __forceinline__ void gemm_phase(PG8_LAS unsigned char* lds, const Gemm g, const Sched& S, const Epi& E) {
    const int tid = threadIdx.x, wid = __builtin_amdgcn_readfirstlane(tid >> 6), lane = tid & 63, wr = wid >> 2, wc = wid & 3, fr = lane & 15, fq = lane >> 4;
    const int K = g.K, nt = K / BK;
    unsigned voffA[2], voffB[2];
#pragma unroll
    for (int i = 0; i < 2; ++i) { int R, C; stage_rc(tid * 16 + i * 8192, R, C); const int Rb = Epi::PERM ? ((R & ~31) + perm32(R & 31)) : R;
        voffA[i] = (unsigned)(R * K + C) * 2u; voffB[i] = (unsigned)(Rb * K + C) * 2u; }
    const size_t kstep = (size_t)(BK * 2);
    const size_t hstep = (size_t)HALF * K * 2;
    const size_t tstep = 2 * hstep;
    const unsigned ldsw = (unsigned)wid * 1024u;
    const int aoff = lds_byte(wr * 64 + fr, fq * 8), boff = lds_byte(wc * 32 + fr, fq * 8);
#define PG8_SA(b, h) (((b) * 2 + (h)) * HTB)
#define PG8_SB(b, h) ((4 + (b) * 2 + (h)) * HTB)
#define PG8_STAGE(bufoff, gbase, voff) do { _Pragma("unroll") for (int _i = 0; _i < 2; ++_i) \
        __builtin_amdgcn_global_load_lds((const unsigned*)((const char*)(gbase) + (voff)[_i]), (PG8_LAS unsigned*)(lds + (bufoff) + ldsw + _i * 8192), 16, 0, 0); } while (0)
#define PG8_LDA(dst, b, h) do { _Pragma("unroll") for (int m = 0; m < 4; ++m) _Pragma("unroll") for (int k = 0; k < 2; ++k) dst[m][k] = *(const PG8_LAS bf16x8*)(lds + PG8_SA(b, h) + aoff + m * 2048 + k * 1024); } while (0)
#define PG8_LDB(dst, b, h) do { _Pragma("unroll") for (int n = 0; n < 2; ++n) _Pragma("unroll") for (int k = 0; k < 2; ++k) dst[n][k] = *(const PG8_LAS bf16x8*)(lds + PG8_SB(b, h) + boff + n * 2048 + k * 1024); } while (0)
#define PG8_MMA(ai, bj, At, Bt) do { __builtin_amdgcn_s_setprio(1); _Pragma("unroll") for (int m = 0; m < 4; ++m) _Pragma("unroll") for (int n = 0; n < 2; ++n) _Pragma("unroll") for (int k = 0; k < 2; ++k) \
        acc[ai][bj][m][n] = __builtin_amdgcn_mfma_f32_16x16x32_bf16(Bt[n][k], At[m][k], acc[ai][bj][m][n], 0, 0, 0); __builtin_amdgcn_s_setprio(0); } while (0)
#define PG8_WAIT_V(n) asm volatile("s_waitcnt vmcnt(" #n ")" ::: "memory")
#define PG8_WAIT_L(n) asm volatile("s_waitcnt lgkmcnt(" #n ")" ::: "memory")
#define PG8_BAR __builtin_amdgcn_s_barrier()
#define PG8_SCHED __builtin_amdgcn_sched_barrier(0)
    Unit cur, nxt; int ui = 0;
    if (!S.next(0, cur)) return;
    f32x4 acc[2][2][4][2];
#pragma unroll
    for (int a = 0; a < 2; ++a)
#pragma unroll
        for (int b = 0; b < 2; ++b)
#pragma unroll
            for (int m = 0; m < 4; ++m)
#pragma unroll
                for (int n = 0; n < 2; ++n) acc[a][b][m][n] = (f32x4){0.f, 0.f, 0.f, 0.f};
    bf16x8 At[4][2], B0[2][2], B1[2][2];
    const char* cA = (const char*)g.A + (size_t)cur.pm * tstep; const char* cB = (const char*)g.Bt + (size_t)cur.pn * tstep;
    S.a_ready(cur);
    if constexpr (SP2) {
        PG8_STAGE(PG8_SB(0, 0), cB, voffB); PG8_STAGE(PG8_SB(0, 1), cB + hstep, voffB); PG8_STAGE(PG8_SA(0, 0), cA, voffA); PG8_STAGE(PG8_SA(0, 1), cA + hstep, voffA);
        if (wr == 1) PG8_BAR;
        PG8_WAIT_V(2); PG8_BAR;
        PG8_STAGE(PG8_SB(1, 0), cB + kstep, voffB); PG8_STAGE(PG8_SA(1, 0), cA + kstep, voffA); PG8_STAGE(PG8_SB(1, 1), cB + hstep + kstep, voffB);
        PG8_WAIT_V(6); PG8_BAR;
    } else {
        PG8_STAGE(PG8_SB(0, 0), cB, voffB); PG8_STAGE(PG8_SA(0, 0), cA, voffA); PG8_STAGE(PG8_SB(0, 1), cB + hstep, voffB); PG8_STAGE(PG8_SA(0, 1), cA + hstep, voffA);
        if (wr == 1) PG8_BAR;
        PG8_WAIT_V(4); PG8_BAR;
        PG8_STAGE(PG8_SB(1, 0), cB + kstep, voffB); PG8_STAGE(PG8_SA(1, 0), cA + kstep, voffA); PG8_STAGE(PG8_SB(1, 1), cB + hstep + kstep, voffB);
        PG8_WAIT_V(6); PG8_BAR;
    }
    for (;;) {
        const bool has_next = S.next(ui + 1, nxt);
        const char* nA = has_next ? (const char*)g.A + (size_t)nxt.pm * tstep : cA; const char* nB = has_next ? (const char*)g.Bt + (size_t)nxt.pn * tstep : cB;
        for (int t = 0; t < nt; t += 2) {
            const bool last = (t == nt - 2);
            const char* a1 = cA + (size_t)(t + 1) * kstep;
            const char* a2 = last ? nA : cA + (size_t)(t + 2) * kstep; const char* b2 = last ? nB : cB + (size_t)(t + 2) * kstep;
            const char* a3 = a2 + kstep; const char* b3 = b2 + kstep;
            if (last && has_next) S.a_ready(nxt);
            if constexpr (SP2) {
            PG8_LDB(B0, 0, 0); PG8_LDB(B1, 0, 1); PG8_SCHED; PG8_LDA(At, 0, 0); PG8_STAGE(PG8_SA(1, 1), a1 + hstep, voffA);
            PG8_WAIT_V(8); PG8_WAIT_L(0); PG8_BAR; PG8_MMA(0, 0, At, B0); PG8_MMA(0, 1, At, B1); PG8_BAR; PG8_SCHED;
            PG8_LDA(At, 0, 1); PG8_STAGE(PG8_SB(0, 0), b2, voffB); PG8_STAGE(PG8_SB(0, 1), b2 + hstep, voffB); PG8_STAGE(PG8_SA(0, 0), a2, voffA);
            PG8_WAIT_V(8); PG8_WAIT_L(0); PG8_BAR; PG8_MMA(1, 0, At, B0); PG8_MMA(1, 1, At, B1); PG8_BAR; PG8_SCHED;
            PG8_LDB(B0, 1, 0); PG8_LDB(B1, 1, 1); PG8_SCHED; PG8_LDA(At, 1, 0); PG8_STAGE(PG8_SA(0, 1), a2 + hstep, voffA);
            PG8_WAIT_V(8); PG8_WAIT_L(0); PG8_BAR; PG8_MMA(0, 0, At, B0); PG8_MMA(0, 1, At, B1); PG8_BAR; PG8_SCHED;
            PG8_LDA(At, 1, 1); PG8_STAGE(PG8_SB(1, 0), b3, voffB); PG8_STAGE(PG8_SB(1, 1), b3 + hstep, voffB); PG8_STAGE(PG8_SA(1, 0), a3, voffA);
            PG8_WAIT_V(8); PG8_WAIT_L(0); PG8_BAR; PG8_MMA(1, 0, At, B0); PG8_MMA(1, 1, At, B1); PG8_BAR; PG8_SCHED;
            } else {
            PG8_LDB(B0, 0, 0); PG8_SCHED; PG8_LDA(At, 0, 0); PG8_STAGE(PG8_SA(1, 1), a1 + hstep, voffA);
            PG8_WAIT_L(8); PG8_BAR; PG8_WAIT_L(0); PG8_MMA(0, 0, At, B0); PG8_BAR; PG8_SCHED;
            PG8_LDB(B1, 0, 1); PG8_STAGE(PG8_SB(0, 0), b2, voffB);
            PG8_BAR; PG8_WAIT_L(0); PG8_MMA(0, 1, At, B1); PG8_BAR;
            PG8_LDA(At, 0, 1); PG8_STAGE(PG8_SA(0, 0), a2, voffA);
            PG8_BAR; PG8_WAIT_L(0); PG8_MMA(1, 0, At, B0); PG8_BAR; PG8_SCHED;
            PG8_STAGE(PG8_SB(0, 1), b2 + hstep, voffB);
            PG8_WAIT_V(6); PG8_BAR; PG8_MMA(1, 1, At, B1); PG8_BAR;
            PG8_LDB(B0, 1, 0); PG8_SCHED; PG8_LDA(At, 1, 0); PG8_STAGE(PG8_SA(0, 1), a2 + hstep, voffA);
            PG8_WAIT_L(8); PG8_BAR; PG8_WAIT_L(0); PG8_MMA(0, 0, At, B0); PG8_BAR; PG8_SCHED;
            PG8_LDB(B1, 1, 1); PG8_STAGE(PG8_SB(1, 0), b3, voffB);
            PG8_BAR; PG8_WAIT_L(0); PG8_MMA(0, 1, At, B1); PG8_BAR;
            PG8_LDA(At, 1, 1); PG8_STAGE(PG8_SA(1, 0), a3, voffA);
            PG8_BAR; PG8_WAIT_L(0); PG8_MMA(1, 0, At, B0); PG8_BAR; PG8_SCHED;
            PG8_STAGE(PG8_SB(1, 1), b3 + hstep, voffB);
            PG8_WAIT_V(6); PG8_BAR; PG8_MMA(1, 1, At, B1); PG8_BAR;
            }
        }
        if constexpr (ALIGN_EPI) { if (wr == 0) PG8_BAR; }
        if constexpr (!Epi::AFTER_DRAIN) { E(acc, cur, wr, wc, fr, fq); S.done(cur); }
        if (!has_next) break;
#pragma unroll
        for (int a = 0; a < 2; ++a)
#pragma unroll
            for (int b = 0; b < 2; ++b)
#pragma unroll
                for (int m = 0; m < 4; ++m)
#pragma unroll
                    for (int n = 0; n < 2; ++n) acc[a][b][m][n] = (f32x4){0.f, 0.f, 0.f, 0.f};
        cur = nxt; cA = nA; cB = nB; ++ui;
        if constexpr (ALIGN_EPI) { if (wr == 1) PG8_BAR; }
    }
    PG8_WAIT_V(0);
    if constexpr (!ALIGN_EPI) { if (wr == 0) PG8_BAR; }
    PG8_BAR;
    if constexpr (Epi::AFTER_DRAIN) { E.fused(acc, cur, wr, wc, fr, fq, lds, wid, lane); S.done(cur); }
#undef PG8_SA
#undef PG8_SB
#undef PG8_STAGE
#undef PG8_LDA
#undef PG8_LDB
#undef PG8_MMA
#undef PG8_WAIT_V
#undef PG8_WAIT_L
#undef PG8_BAR
#undef PG8_SCHED
}
}

#define DI __device__ __forceinline__
#define LAS __attribute__((address_space(3)))
typedef unsigned short bf16_t;
typedef short bf16x8 __attribute__((ext_vector_type(8)));
typedef short s16x4 __attribute__((ext_vector_type(4)));
typedef float f32x4 __attribute__((ext_vector_type(4)));
typedef float f32x16 __attribute__((ext_vector_type(16)));
typedef unsigned u32x4 __attribute__((ext_vector_type(4)));
typedef LAS unsigned char* lptr;
constexpr int NTHR = 512, NWAVES = 8;
constexpr int BATCH = 2, SEQ = 4096, DM = 2048, MTOK = BATCH * SEQ;
constexpr int DIN = 4096, NPROJ = 20736;
constexpr int OFF_Z = 0, OFF_XBC = 4096, OFF_Q = 10240, OFF_K = 12288, OFF_V = 14336, OFF_G = 16384, OFF_DT = 20480;
constexpr int FFN = 5632, NUP = 2 * FFN;
constexpr float EPS = 1e-6f;
constexpr size_t MiB = 1u << 20;
constexpr size_t WS_CTL = 0, WS_WIN = 1 * MiB, WS_WSSM = 82 * MiB, WS_WATT = 98 * MiB, WS_WO = 106 * MiB, WS_WUP = 114 * MiB, WS_WDN = 158 * MiB,
                 WS_U = 180 * MiB, WS_Y = 212 * MiB, WS_PROJ = 276 * MiB, WS_SB = 600 * MiB  , WS_DT = 618 * MiB  , WS_END = 620 * MiB;
constexpr size_t WS_ST = WS_WIN  , WS_MIX = WS_WIN  , WS_H = WS_PROJ  ;
constexpr size_t SB_STRIDE = (size_t)(MTOK / 64) * 2 * FFN * 4;
constexpr size_t CTL_ROWSS = 0, CTL_CD = 65536, CTL_BAR = 131072, CTL_BAR_BYTES = 16384;
constexpr int LDS_BYTES = 150 * 1024;

DI unsigned pk2(float lo, float hi) { return pg8::cvt_pk_bf16(lo, hi); }
DI float bflo(unsigned w) { return __uint_as_float(w << 16); }
DI float bfhi(unsigned w) { return __uint_as_float(w & 0xffff0000u); }
DI float bf1(bf16_t h) { return __uint_as_float((unsigned)h << 16); }
DI float wave_sum(float v) {
#pragma unroll
    for (int o = 1; o < 64; o <<= 1) v += __shfl_xor(v, o);
    return v;
}
DI float siluf_(float v) { return v * __builtin_amdgcn_rcpf(1.0f + __expf(-v)); }
DI float softplusf_(float v) { return fmaxf(v, 0.f) + log1pf(__expf(-fabsf(v))); }
#define MFMA32(a, b, c) __builtin_amdgcn_mfma_f32_32x32x16_bf16((a), (b), (c), 0, 0, 0)
DI int crow(int r, int hi) { return (r & 3) + 8 * (r >> 2) + 4 * hi; }
typedef short v4i16_t __attribute__((ext_vector_type(4)));
DI s16x4 trread(lptr p) { return __builtin_bit_cast(s16x4, __builtin_amdgcn_ds_read_tr16_b64_v4i16((LAS v4i16_t*)p)); }
DI bf16x8 trfrag(lptr plo, lptr phi) { const s16x4 a = trread(plo), b = trread(phi); return __builtin_shufflevector(a, b, 0, 1, 2, 3, 4, 5, 6, 7); }
DI int tr_off(int lane, int rs) { const int i = lane & 15; return (i >> 2) * rs + (((lane >> 4) & 1) * 16 + (i & 3) * 4) * 2; }

struct Args { const float* in[20]; float* out; unsigned char* ws; int ph_lo, ph_hi; };

struct TrItem { const float* src; bf16_t* dst; int K, N; };
DI TrItem p0_decode(const Args& a, int it) {
    constexpr int I_IN = (DM / 64) * (20544 / 64), I_SSM = (DIN / 64) * (DM / 64), I_ATT = (DM / 64) * (DM / 64), I_O = I_ATT, I_UP = (DM / 64) * (NUP / 64);
    const float* W; bf16_t* WT; int K, N, map = 0, r = it; unsigned char* ws = a.ws;
    if (r < I_IN) { W = a.in[2]; WT = (bf16_t*)(ws + WS_WIN); K = DM; N = 20544; map = 1; }
    else if ((r -= I_IN) < I_SSM) { W = a.in[12]; WT = (bf16_t*)(ws + WS_WSSM); K = DIN; N = DM; }
    else if ((r -= I_SSM) < I_ATT) { W = a.in[13]; WT = (bf16_t*)(ws + WS_WATT); K = DM; N = DM; }
    else if ((r -= I_ATT) < I_O) { W = a.in[14]; WT = (bf16_t*)(ws + WS_WO); K = DM; N = DM; }
    else if ((r -= I_O) < I_UP) { W = a.in[16]; WT = (bf16_t*)(ws + WS_WUP); K = DM; N = NUP; map = 2; }
    else { r -= I_UP; W = a.in[19]; WT = (bf16_t*)(ws + WS_WDN); K = FFN; N = DM; }
    const int nblk = N / 64, kb = r / nblk, nb = r % nblk, k0 = 64 * kb, n0 = 64 * nb;
    int d0 = n0;
    if (map == 1) { if (n0 >= 10304) d0 = n0 - 64; else if (n0 >= 10240) d0 = OFF_DT + (n0 - 10240); }
    if (map == 2) { const int g_ = n0 >= FFN, n1 = n0 - g_ * FFN; d0 = 256 * (n1 >> 7) + 128 * g_ + (n1 & 127); }
    TrItem t; t.src = W + (size_t)k0 * N + n0; t.dst = WT + (size_t)d0 * K + k0; t.K = K; t.N = N; return t;
}
DI void p0_tr_load(f32x4 (&v)[16], const TrItem& t, int lane) {
    const int c = lane & 15, rsub = lane >> 4;
#pragma unroll
    for (int i = 0; i < 16; ++i) v[i] = __builtin_nontemporal_load((const f32x4*)(t.src + (size_t)(4 * i + rsub) * t.N + 4 * c));
}
DI void p0_tr_store(const f32x4 (&v)[16], const TrItem& t, LAS float* scr, int lane) {
    const int c = lane & 15, rsub = lane >> 4;
#pragma unroll
    for (int i = 0; i < 16; ++i) { LAS float* d = scr + (4 * i + rsub) * 65 + 4 * c; d[0] = v[i].x; d[1] = v[i].y; d[2] = v[i].z; d[3] = v[i].w; }
    asm volatile("s_waitcnt lgkmcnt(0)" ::: "memory");
    const int kc = lane & 7, nsub = lane >> 3;
#pragma unroll
    for (int j = 0; j < 8; ++j) { const int n = nsub + 8 * j; const LAS float* s = scr + (8 * kc) * 65 + n;
        u32x4 o; o.x = pk2(s[0 * 65], s[1 * 65]); o.y = pk2(s[2 * 65], s[3 * 65]); o.z = pk2(s[4 * 65], s[5 * 65]); o.w = pk2(s[6 * 65], s[7 * 65]);
        *(u32x4*)(t.dst + (size_t)n * t.K + 8 * kc) = o; }
    asm volatile("s_waitcnt lgkmcnt(0)" ::: "memory");
}
DI void wdn_convert(const Args& a, lptr lds, int widx, int nw) {
    const int lane = threadIdx.x & 63, wave = threadIdx.x >> 6;
    LAS float* scr = (LAS float*)(lds + wave * 16640);
    constexpr int NB = DM / 64, NIT = (FFN / 64) * NB;
    f32x4 v[16];
    for (int it = widx; it < NIT; it += nw) {
        const int kb = it / NB, nb = it % NB;
        TrItem t; t.src = a.in[19] + (size_t)(64 * kb) * DM + 64 * nb; t.dst = (bf16_t*)(a.ws + WS_WDN) + (size_t)(64 * nb) * FFN + 64 * kb; t.K = FFN; t.N = DM;
        p0_tr_load(v, t, lane);
        p0_tr_store(v, t, scr, lane);
    }
}
DI void p0_prologue(const Args& a, lptr lds, int vcu, int G) {
    const int tid = threadIdx.x, lane = tid & 63, wave = tid >> 6;
    unsigned char* ws = a.ws;
    LAS float* scr = (LAS float*)(lds + wave * 16640);
    const int gw = vcu * NWAVES + wave, NGW = G * NWAVES;
    const int gt = blockIdx.x * NTHR + tid, NGT = G * NTHR;
    for (int i = gt; i < MTOK; i += NGT) ((float*)(ws + WS_CTL + CTL_ROWSS))[i] = 0.f;
    constexpr int NITEMS = (DM / 64) * (20544 / 64) + (DIN / 64) * (DM / 64) + 2 * (DM / 64) * (DM / 64) + (DM / 64) * (NUP / 64);
    if (gw < NITEMS) {
        f32x4 va[16], vb[16];
        TrItem ta = p0_decode(a, gw), tb = ta;
        p0_tr_load(va, ta, lane);
        for (int it = gw; it < NITEMS; it += 2 * NGW) {
            const bool hb = it + NGW < NITEMS;
            if (hb) { tb = p0_decode(a, it + NGW); p0_tr_load(vb, tb, lane); }
            p0_tr_store(va, ta, scr, lane);
            if (!hb) break;
            const bool ha = it + 2 * NGW < NITEMS;
            if (ha) { ta = p0_decode(a, it + 2 * NGW); p0_tr_load(va, ta, lane); }
            p0_tr_store(vb, tb, scr, lane);
            if (!ha) break;
        }
    }
    const float* x = a.in[0]; const float* nw = a.in[1]; bf16_t* U = (bf16_t*)(ws + WS_U);
    for (int m = gw; m < MTOK; m += NGW) {
        const f32x4* xr = (const f32x4*)(x + (size_t)m * DM) + lane;
        f32x4 v[8]; float s = 0.f;
#pragma unroll
        for (int j = 0; j < 8; ++j) { v[j] = __builtin_nontemporal_load(xr + 64 * j); s += (v[j].x * v[j].x + v[j].y * v[j].y) + (v[j].z * v[j].z + v[j].w * v[j].w); }
        const float r = __builtin_amdgcn_rsqf(wave_sum(s) * (1.0f / DM) + EPS);
        unsigned long long* o8 = (unsigned long long*)(U + (size_t)m * DM) + lane;
#pragma unroll
        for (int j = 0; j < 8; ++j) { const f32x4 w = ((const f32x4*)nw)[64 * j + lane];
            o8[64 * j] = (unsigned long long)pk2(v[j].x * r * w.x, v[j].y * r * w.y) | ((unsigned long long)pk2(v[j].z * r * w.z, v[j].w * r * w.w) << 32); }
    }
}

DI void dt_gemm(const Args& a, lptr lds, int vcu, int G) {
    const int tid = threadIdx.x, lane = tid & 63, wid = __builtin_amdgcn_readfirstlane(tid >> 6), r32 = lane & 31, hi = lane >> 5;
    const bf16_t* U = (const bf16_t*)(a.ws + WS_U); const bf16_t* Wd = (const bf16_t*)(a.ws + WS_WIN) + (size_t)OFF_DT * DM;
    float* DT = (float*)(a.ws + WS_DT);
    LAS float* red = (LAS float*)lds;
    for (int rb = vcu; rb < MTOK / 32; rb += G) {
        const int kbase = wid * 256 + 8 * hi;
        f32x16 acc[2];
#pragma unroll
        for (int nb = 0; nb < 2; ++nb)
#pragma unroll
            for (int k = 0; k < 16; ++k) acc[nb][k] = 0.f;
        const bf16_t* ap = U + (size_t)(rb * 32 + r32) * DM + kbase; const bf16_t* bp = Wd + (size_t)r32 * DM + kbase;
#pragma unroll 4
        for (int ks = 0; ks < 16; ++ks) { const bf16x8 af = *(const bf16x8*)(ap + 16 * ks), b0 = *(const bf16x8*)(bp + 16 * ks), b1 = *(const bf16x8*)(bp + (size_t)32 * DM + 16 * ks);
            acc[0] = MFMA32(af, b0, acc[0]); acc[1] = MFMA32(af, b1, acc[1]); }
#pragma unroll
        for (int nb = 0; nb < 2; ++nb)
#pragma unroll
            for (int i = 0; i < 16; ++i) red[(wid * 2 + nb) * 1024 + crow(i, hi) * 32 + r32] = acc[nb][i];
        __syncthreads();
        for (int o = tid; o < 2048; o += NTHR) { const int nb = o >> 10, rem = o & 1023; float sacc = 0.f;
#pragma unroll
            for (int w = 0; w < 8; ++w) sacc += red[(w * 2 + nb) * 1024 + rem];
            DT[(size_t)(rb * 32 + (rem >> 5)) * 64 + nb * 32 + (rem & 31)] = sacc; }
        __syncthreads();
    }
}

template <int NT> DI void conv_load(u32x4 (&raw)[NT + 3], const bf16_t* srow, int seq0, int col, int t0) {
#pragma unroll
    for (int i = 0; i < NT + 3; ++i) { const int t = t0 - 3 + i; const bool ok = (seq0 + t) >= 0; raw[i] = *(const u32x4*)(srow + (ptrdiff_t)(ok ? t : 0) * NPROJ + col); if (!ok) raw[i] = (u32x4){0u, 0u, 0u, 0u}; }
}
template <int NT> DI void conv_compute(const u32x4 (&raw)[NT + 3], int col, const float* cw, const float* cb, int t0, lptr dst, int rs, int dbyte, const LAS float* scale) {
    const int ch = col - OFF_XBC;
    float w[4][8], bs[8], h0[8], h1[8], h2[8];
#pragma unroll
    for (int k = 0; k < 4; ++k) { const f32x4 a = *(const f32x4*)(cw + (size_t)k * 6144 + ch), b = *(const f32x4*)(cw + (size_t)k * 6144 + ch + 4);
        w[k][0] = a.x; w[k][1] = a.y; w[k][2] = a.z; w[k][3] = a.w; w[k][4] = b.x; w[k][5] = b.y; w[k][6] = b.z; w[k][7] = b.w; }
    { const f32x4 a = *(const f32x4*)(cb + ch), b = *(const f32x4*)(cb + ch + 4); bs[0] = a.x; bs[1] = a.y; bs[2] = a.z; bs[3] = a.w; bs[4] = b.x; bs[5] = b.y; bs[6] = b.z; bs[7] = b.w; }
#define CV_UNPACK(dstv, r_) do { dstv[0] = bflo(r_.x); dstv[1] = bfhi(r_.x); dstv[2] = bflo(r_.y); dstv[3] = bfhi(r_.y); dstv[4] = bflo(r_.z); dstv[5] = bfhi(r_.z); dstv[6] = bflo(r_.w); dstv[7] = bfhi(r_.w); } while (0)
    CV_UNPACK(h0, raw[0]); CV_UNPACK(h1, raw[1]); CV_UNPACK(h2, raw[2]);
#pragma unroll
    for (int tt = 0; tt < NT; ++tt) {
        float cur[8], y[8]; CV_UNPACK(cur, raw[3 + tt]);
        const float sc = scale ? scale[t0 + tt] : 1.0f;
#pragma unroll
        for (int j = 0; j < 8; ++j) { const float v = bs[j] + w[0][j] * h0[j] + w[1][j] * h1[j] + w[2][j] * h2[j] + w[3][j] * cur[j]; y[j] = siluf_(v) * sc; h0[j] = h1[j]; h1[j] = h2[j]; h2[j] = cur[j]; }
        u32x4 o; o.x = pk2(y[0], y[1]); o.y = pk2(y[2], y[3]); o.z = pk2(y[4], y[5]); o.w = pk2(y[6], y[7]);
        *(LAS u32x4*)(dst + (t0 + tt) * rs + dbyte) = o;
    }
#undef CV_UNPACK
}

DI void ssd_dt(const Args& a, const float* dtrow, int g, LAS float* dtv, LAS float* acs, float* cd_out) {
    const int lane = threadIdx.x & 63, e = threadIdx.x >> 6, head = g * 8 + e;
    const float bias = a.in[5][head], A = -__expf(a.in[6][head]);
    const float d0 = softplusf_(dtrow[(2 * lane) * 64 + head] + bias), d1 = softplusf_(dtrow[(2 * lane + 1) * 64 + head] + bias);
    const float a0 = d0 * A, a1 = d1 * A; float inc = a0 + a1;
#pragma unroll
    for (int o = 1; o < 64; o <<= 1) { const float t = __shfl_up(inc, o); if (lane >= o) inc += t; }
    dtv[e * 128 + 2 * lane] = d0; dtv[e * 128 + 2 * lane + 1] = d1;
    acs[e * 128 + 2 * lane] = inc - a1; acs[e * 128 + 2 * lane + 1] = inc;
    if (cd_out && lane == 63) cd_out[head] = __expf(inc);
}

DI void ssd_states_unit(const Args& a, lptr lds, int b, int c, int g) {
    int tid_ = threadIdx.x; asm volatile("" : "+v"(tid_));
    const int tid = tid_, lane = tid & 63, wid = __builtin_amdgcn_readfirstlane(tid >> 6), r32 = lane & 31, hi = lane >> 5;
    const bf16_t* proj = (const bf16_t*)(a.ws + WS_PROJ);
    const bf16_t* srow = proj + (size_t)(b * SEQ + c * 128) * NPROJ;
    const int seq0 = c * 128;
    constexpr int RSB = 288, RSX = 544;
    lptr Bn = lds, Xn = lds + 128 * RSB; LAS float* dtv = (LAS float*)(lds + 128 * RSB + 128 * RSX); LAS float* acs = dtv + 1024; LAS float* wsc = acs + 1024;
    float* cd = (float*)(a.ws + WS_CTL + CTL_CD) + (size_t)(b * 32 + c) * 64;
    const int bcol = OFF_XBC + DIN + g * 128 + (tid & 15) * 8, xcc = tid & 31, xtg = tid >> 5;
    u32x4 rawB[11], rawX[11];
    if (tid < 256) conv_load<8>(rawB, srow, seq0, bcol, (tid >> 4) * 8);
    conv_load<8>(rawX, srow, seq0, OFF_XBC + g * 512 + xcc * 8, xtg * 8);
    ssd_dt(a, (const float*)(a.ws + WS_DT) + (size_t)(b * SEQ + c * 128) * 64, g, dtv, acs, cd);
    __syncthreads();
    for (int i = tid; i < 1024; i += NTHR) { const int e = i >> 7; wsc[i] = dtv[i] * __expf(acs[e * 128 + 127] - acs[i]); }
    if (tid < 256) conv_compute<8>(rawB, bcol, a.in[3], a.in[4], (tid >> 4) * 8, Bn, RSB, (tid & 15) * 16, nullptr);
    bf16_t* ST = (bf16_t*)(a.ws + WS_ST) + (size_t)((b * 32 + c) * 64 + g * 8) * 8192;
    const int tro_b = tr_off(lane, RSB), tro_x = tr_off(lane, RSX);
    for (int r = 0; r < 2; ++r) {
        __syncthreads();
        conv_compute<8>(rawX, OFF_XBC + g * 512 + r * 256 + xcc * 8, a.in[3], a.in[4], xtg * 8, Xn, RSX, xcc * 16, wsc + (r * 4 + (xcc >> 3)) * 128);
        __syncthreads();
        if (r == 0) conv_load<8>(rawX, srow, seq0, OFF_XBC + g * 512 + 256 + xcc * 8, xtg * 8);
        const int hl = wid >> 1, nh = wid & 1;
        f32x16 acc[2][2];
#pragma unroll
        for (int i = 0; i < 2; ++i)
#pragma unroll
            for (int j = 0; j < 2; ++j)
#pragma unroll
                for (int k = 0; k < 16; ++k) acc[i][j][k] = 0.f;
#pragma unroll 2
        for (int ks = 0; ks < 8; ++ks) {
            const int krow = 16 * ks + 8 * hi;
            bf16x8 af[2], bfr[2];
#pragma unroll
            for (int pb = 0; pb < 2; ++pb) { lptr p = Xn + krow * RSX + (hl * 64 + 32 * pb) * 2 + tro_x; af[pb] = trfrag(p, p + 4 * RSX); }
#pragma unroll
            for (int nb = 0; nb < 2; ++nb) { lptr p = Bn + krow * RSB + (64 * nh + 32 * nb) * 2 + tro_b; bfr[nb] = trfrag(p, p + 4 * RSB); }
#pragma unroll
            for (int pb = 0; pb < 2; ++pb)
#pragma unroll
                for (int nb = 0; nb < 2; ++nb) acc[pb][nb] = MFMA32(bfr[nb], af[pb], acc[pb][nb]);
        }
        bf16_t* dst = ST + (size_t)(r * 4 + hl) * 8192;
#pragma unroll
        for (int pb = 0; pb < 2; ++pb)
#pragma unroll
            for (int nb = 0; nb < 2; ++nb)
#pragma unroll
                for (int gq = 0; gq < 4; ++gq) { const unsigned long long w = (unsigned long long)pk2(acc[pb][nb][4 * gq], acc[pb][nb][4 * gq + 1]) | ((unsigned long long)pk2(acc[pb][nb][4 * gq + 2], acc[pb][nb][4 * gq + 3]) << 32);
                    *(unsigned long long*)(dst + (32 * pb + r32) * 128 + 64 * nh + 32 * nb + 8 * gq + 4 * hi) = w; }
    }
    __syncthreads();
}

DI void attn_unit(const Args& a, lptr lds, int b, int h, int qb) {
    int tid_ = threadIdx.x; asm volatile("" : "+v"(tid_));
    const int tid = tid_, lane = tid & 63, wid = __builtin_amdgcn_readfirstlane(tid >> 6), r32 = lane & 31, hi = lane >> 5;
    const bf16_t* proj = (const bf16_t*)(a.ws + WS_PROJ);
    bf16_t* att = (bf16_t*)(a.ws + WS_U);
    const size_t rowbase = (size_t)b * SEQ; const int q0 = qb * 256;
    constexpr int RSK = 272, RSV = 288;
    lptr Qs = lds, Ks = lds, Vs = lds + 64 * RSK;
    const int dc = tid & 15, rsub = tid >> 4;
    float wn[8];
    { const f32x4 w0 = *(const f32x4*)(a.in[9] + dc * 8), w1 = *(const f32x4*)(a.in[9] + dc * 8 + 4); const float sc = 0.08838834764831845f * 1.4426950408889634f;
      wn[0] = w0.x * sc; wn[1] = w0.y * sc; wn[2] = w0.z * sc; wn[3] = w0.w * sc; wn[4] = w1.x * sc; wn[5] = w1.y * sc; wn[6] = w1.z * sc; wn[7] = w1.w * sc; }
#pragma unroll 2
    for (int i = 0; i < 8; ++i) { const int row = rsub + 32 * i;
        const u32x4 r_ = *(const u32x4*)(proj + (rowbase + q0 + row) * NPROJ + OFF_Q + h * 128 + dc * 8);
        float f[8] = {bflo(r_.x), bfhi(r_.x), bflo(r_.y), bfhi(r_.y), bflo(r_.z), bfhi(r_.z), bflo(r_.w), bfhi(r_.w)};
        float ss = 0.f;
#pragma unroll
        for (int j = 0; j < 8; ++j) ss += f[j] * f[j];
        ss += __shfl_xor(ss, 1); ss += __shfl_xor(ss, 2); ss += __shfl_xor(ss, 4); ss += __shfl_xor(ss, 8);
        const float rn = __builtin_amdgcn_rsqf(ss * (1.0f / 128.0f) + EPS);
        u32x4 o; o.x = pk2(f[0] * rn * wn[0], f[1] * rn * wn[1]); o.y = pk2(f[2] * rn * wn[2], f[3] * rn * wn[3]); o.z = pk2(f[4] * rn * wn[4], f[5] * rn * wn[5]); o.w = pk2(f[6] * rn * wn[6], f[7] * rn * wn[7]);
        *(LAS u32x4*)(Qs + row * RSK + dc * 16) = o; }
    __syncthreads();
    bf16x8 qf[8];
#pragma unroll
    for (int ds = 0; ds < 8; ++ds) qf[ds] = *(const LAS bf16x8*)(Qs + (wid * 32 + r32) * RSK + (16 * ds + 8 * hi) * 2);
    __syncthreads();
    { const f32x4 w0 = *(const f32x4*)(a.in[10] + dc * 8), w1 = *(const f32x4*)(a.in[10] + dc * 8 + 4);
      wn[0] = w0.x; wn[1] = w0.y; wn[2] = w0.z; wn[3] = w0.w; wn[4] = w1.x; wn[5] = w1.y; wn[6] = w1.z; wn[7] = w1.w; }
    f32x16 o[4];
#pragma unroll
    for (int d0 = 0; d0 < 4; ++d0)
#pragma unroll
        for (int k = 0; k < 16; ++k) o[d0][k] = 0.f;
    float R = 0.f;
    LAS int* flags = (LAS int*)(lds + 256 * RSK);
    if (lane == 0) flags[wid] = 0;
    bool mydone = false;
    const int qw0 = q0 + wid * 32, qpos = qw0 + r32;
    const int ntiles = (q0 + 256) / 64;
    const bf16_t* kvbase = proj + rowbase * NPROJ + h * 128 + dc * 8;
    u32x4 kreg[2], vreg[2];
#define AT_PREFETCH(kt) do { _Pragma("unroll") for (int i_ = 0; i_ < 2; ++i_) { const bf16_t* p_ = kvbase + (size_t)((kt) * 64 + rsub + 32 * i_) * NPROJ; \
        kreg[i_] = *(const u32x4*)(p_ + OFF_K); vreg[i_] = *(const u32x4*)(p_ + OFF_V); } } while (0)
    AT_PREFETCH(ntiles - 1);
    const int tro_v = tr_off(lane, RSV);
    for (int kt = ntiles - 1; kt >= 0; --kt) {
#pragma unroll
        for (int i = 0; i < 2; ++i) { const int key = rsub + 32 * i; const u32x4 r_ = kreg[i];
            float f[8] = {bflo(r_.x), bfhi(r_.x), bflo(r_.y), bfhi(r_.y), bflo(r_.z), bfhi(r_.z), bflo(r_.w), bfhi(r_.w)};
            float ss = 0.f;
#pragma unroll
            for (int j = 0; j < 8; ++j) ss += f[j] * f[j];
            ss += __shfl_xor(ss, 1); ss += __shfl_xor(ss, 2); ss += __shfl_xor(ss, 4); ss += __shfl_xor(ss, 8);
            const float rn = __builtin_amdgcn_rsqf(ss * (1.0f / 128.0f) + EPS);
            u32x4 w; w.x = pk2(f[0] * rn * wn[0], f[1] * rn * wn[1]); w.y = pk2(f[2] * rn * wn[2], f[3] * rn * wn[3]); w.z = pk2(f[4] * rn * wn[4], f[5] * rn * wn[5]); w.w = pk2(f[6] * rn * wn[6], f[7] * rn * wn[7]);
            *(LAS u32x4*)(Ks + key * RSK + dc * 16) = w;
            *(LAS u32x4*)(Vs + key * RSV + dc * 16) = vreg[i]; }
        __syncthreads();
        if (kt > 0) AT_PREFETCH(kt - 1);
        const int key0 = kt * 64;
        if (!mydone && key0 < qw0 + 31) {
#pragma unroll
            for (int blk = 1; blk >= 0; --blk) {
                const int kb0 = key0 + 32 * blk;
                if (kb0 < qw0 + 31) {
                    f32x16 z;
#pragma unroll
                    for (int k = 0; k < 16; ++k) z[k] = 0.f;
#pragma unroll
                    for (int ds = 0; ds < 8; ++ds) { const bf16x8 kf = *(const LAS bf16x8*)(Ks + (32 * blk + r32) * RSK + (16 * ds + 8 * hi) * 2); z = MFMA32(kf, qf[ds], z); }
                    float lk[16], lb[16];
#pragma unroll
                    for (int i = 0; i < 16; ++i) { const float zz = z[i]; const float l1p = __builtin_amdgcn_logf(1.0f + __builtin_amdgcn_exp2f(-fabsf(zz)));
                        const float lbv = fminf(zz, 0.f) - l1p, lkv = lbv - zz; const bool valid = (kb0 + crow(i, hi)) < qpos;
                        lk[i] = valid ? lkv : 0.f; lb[i] = valid ? lbv : -INFINITY; }
                    float suf[16], gs[4], pgs[4], aft[4];
#pragma unroll
                    for (int j = 0; j < 4; ++j) { suf[4 * j + 3] = 0.f; suf[4 * j + 2] = lk[4 * j + 3]; suf[4 * j + 1] = suf[4 * j + 2] + lk[4 * j + 2]; suf[4 * j] = suf[4 * j + 1] + lk[4 * j + 1]; gs[j] = suf[4 * j] + lk[4 * j]; }
#pragma unroll
                    for (int j = 0; j < 4; ++j) pgs[j] = __shfl_xor(gs[j], 32);
                    const float T0 = gs[0] + pgs[0], T1 = gs[1] + pgs[1], T2 = gs[2] + pgs[2], T3 = gs[3] + pgs[3];
                    const float SP2 = T3, SP1 = SP2 + T2, SP0 = SP1 + T1, total = SP0 + T0;
                    aft[3] = 0.f; aft[2] = SP2; aft[1] = SP1; aft[0] = SP0;
                    if (hi == 0) {
#pragma unroll
                        for (int j = 0; j < 4; ++j) aft[j] += pgs[j]; }
                    float p[16];
#pragma unroll
                    for (int i = 0; i < 16; ++i) p[i] = __builtin_amdgcn_exp2f(lb[i] + (R + aft[i >> 2] + suf[i]));
                    R += total;
                    bf16x8 pa[2];
#pragma unroll
                    for (int s = 0; s < 2; ++s) { u32x4 w; w.x = pk2(p[8 * s], p[8 * s + 1]); w.y = pk2(p[8 * s + 2], p[8 * s + 3]); w.z = pk2(p[8 * s + 4], p[8 * s + 5]); w.w = pk2(p[8 * s + 6], p[8 * s + 7]); pa[s] = __builtin_bit_cast(bf16x8, w); }
#pragma unroll
                    for (int s = 0; s < 2; ++s)
#pragma unroll
                        for (int d0 = 0; d0 < 4; ++d0) { lptr vp = Vs + (32 * blk + 16 * s + 4 * hi) * RSV + (32 * d0) * 2 + tro_v; const bf16x8 vf = trfrag(vp, vp + 8 * RSV); o[d0] = MFMA32(vf, pa[s], o[d0]); }
                }
            }
            mydone = __all(R < -150.1f);
            if (mydone && lane == 0) flags[wid] = 1;
        }
        __syncthreads();
        { int alld = 1;
#pragma unroll
          for (int w = 0; w < 8; ++w) alld &= flags[w];
          if (alld) break; }
    }
    __syncthreads();
#undef AT_PREFETCH
    bf16_t* orow = att + (rowbase + qw0 + r32) * DM + h * 128 + 4 * hi;
#pragma unroll
    for (int d0 = 0; d0 < 4; ++d0)
#pragma unroll
        for (int gq = 0; gq < 4; ++gq) { const unsigned long long w = (unsigned long long)pk2(o[d0][4 * gq], o[d0][4 * gq + 1]) | ((unsigned long long)pk2(o[d0][4 * gq + 2], o[d0][4 * gq + 3]) << 32);
            *(unsigned long long*)(orow + 32 * d0 + 8 * gq) = w; }
}

DI void ssd_scan(const Args& a) {
    bf16_t* ST = (bf16_t*)(a.ws + WS_ST); const float* cd = (const float*)(a.ws + WS_CTL + CTL_CD);
    const int NIT = BATCH * 64 * 8192 / 8;
    for (int it = blockIdx.x * NTHR + threadIdx.x; it < NIT; it += gridDim.x * NTHR) {
        const int b = it / (64 * 1024), rem = it % (64 * 1024), head = rem / 1024;
        float run[8];
#pragma unroll
        for (int j = 0; j < 8; ++j) run[j] = 0.f;
        u32x4* p = (u32x4*)(ST + (size_t)b * 32 * 64 * 8192 + (size_t)rem * 8);
        constexpr size_t CS = 64 * 8192 / 8;
#pragma unroll 1
        for (int c0 = 0; c0 < 32; c0 += 8) {
            u32x4 v[8]; float d[8];
#pragma unroll
            for (int k = 0; k < 8; ++k) { v[k] = p[(size_t)(c0 + k) * CS]; d[k] = cd[(b * 32 + c0 + k) * 64 + head]; }
#pragma unroll
            for (int k = 0; k < 8; ++k) {
                u32x4 o; o.x = pk2(run[0], run[1]); o.y = pk2(run[2], run[3]); o.z = pk2(run[4], run[5]); o.w = pk2(run[6], run[7]);
                const float dd = d[k]; const u32x4 vv = v[k];
                run[0] = run[0] * dd + bflo(vv.x); run[1] = run[1] * dd + bfhi(vv.x); run[2] = run[2] * dd + bflo(vv.y); run[3] = run[3] * dd + bfhi(vv.y);
                run[4] = run[4] * dd + bflo(vv.z); run[5] = run[5] * dd + bfhi(vv.z); run[6] = run[6] * dd + bflo(vv.w); run[7] = run[7] * dd + bfhi(vv.w);
                v[k] = o; }
#pragma unroll
            for (int k = 0; k < 8; ++k) p[(size_t)(c0 + k) * CS] = v[k];
        }
    }
}

DI void ssd_out_unit(const Args& a, lptr lds, int b, int c, int g) {
    int tid_ = threadIdx.x; asm volatile("" : "+v"(tid_));
    const int tid = tid_, lane = tid & 63, wid = __builtin_amdgcn_readfirstlane(tid >> 6), r32 = lane & 31, hi = lane >> 5;
    const bf16_t* proj = (const bf16_t*)(a.ws + WS_PROJ);
    const size_t row0 = (size_t)b * SEQ + c * 128;
    const bf16_t* srow = proj + row0 * NPROJ;
    const int seq0 = c * 128;
    constexpr int RSC = 272, RSX = 544;
    lptr Cn = lds, CBh = lds + 128 * RSC, Bn = CBh + 128 * RSC, Xn = Bn; LAS float* dtv = (LAS float*)(Bn + 128 * RSX); LAS float* acs = dtv + 1024;
    bf16_t* Y = (bf16_t*)(a.ws + WS_Y);
    const int cbcol = OFF_XBC + DIN + (tid < 256 ? 1024 : 0) + g * 128 + (tid & 15) * 8, cbt0 = ((tid & 255) >> 4) * 8;
    const int xcol = OFF_XBC + g * 512 + (tid & 31) * 8, xt0 = (tid >> 5) * 8;
    u32x4 rawCB[11], rawX[11];
    conv_load<8>(rawCB, srow, seq0, cbcol, cbt0);
    conv_load<8>(rawX, srow, seq0, xcol, xt0);
    ssd_dt(a, (const float*)(a.ws + WS_DT) + row0 * 64, g, dtv, acs, nullptr);
    conv_compute<8>(rawCB, cbcol, a.in[3], a.in[4], cbt0, tid < 256 ? Cn : Bn, RSC, (tid & 15) * 16, nullptr);
    __syncthreads();
    { const int qbk = wid >> 1;
#pragma unroll
      for (int sbi = 0; sbi < 2; ++sbi) { const int sb = 2 * (wid & 1) + sbi;
        if (sb <= qbk) {
            f32x16 acc;
#pragma unroll
            for (int k = 0; k < 16; ++k) acc[k] = 0.f;
#pragma unroll
            for (int ks = 0; ks < 8; ++ks) { const bf16x8 af = *(const LAS bf16x8*)(Cn + (32 * qbk + r32) * RSC + (16 * ks + 8 * hi) * 2), bf_ = *(const LAS bf16x8*)(Bn + (32 * sb + r32) * RSC + (16 * ks + 8 * hi) * 2);
                acc = MFMA32(af, bf_, acc); }
#pragma unroll
            for (int i = 0; i < 16; ++i) *(LAS bf16_t*)(CBh + (32 * qbk + crow(i, hi)) * RSC + (32 * sb + r32) * 2) = (bf16_t)(pk2(acc[i], 0.f) & 0xffffu);
        } } }
    const int tro_x = tr_off(lane, RSX);
    const bf16_t* PV = (const bf16_t*)(a.ws + WS_ST) + (size_t)((b * 32 + c) * 64 + g * 8) * 8192;
    for (int r = 0; r < 2; ++r) {
        const int hl = wid >> 1, e = 4 * r + hl, head = g * 8 + e, qp = wid & 1;
        __syncthreads();
        const bf16_t* pv = PV + (size_t)e * 8192;
        bf16x8 pvf[8][2];
#pragma unroll
        for (int ks = 0; ks < 8; ++ks)
#pragma unroll
            for (int pb = 0; pb < 2; ++pb) pvf[ks][pb] = *(const bf16x8*)(pv + (32 * pb + r32) * 128 + 16 * ks + 8 * hi);
        conv_compute<8>(rawX, xcol + r * 256, a.in[3], a.in[4], xt0, Xn, RSX, (tid & 31) * 16, nullptr);
        __syncthreads();
        if (r == 0) conv_load<8>(rawX, srow, seq0, xcol + 256, xt0);
        const float dsk = a.in[7][head];
#pragma unroll 1
        for (int qs = 0; qs < 2; ++qs) {
            const int qbk = 2 * qp + qs, q = 32 * qbk + r32;
            f32x16 acc[2];
#pragma unroll
            for (int pb = 0; pb < 2; ++pb)
#pragma unroll
                for (int k = 0; k < 16; ++k) acc[pb][k] = 0.f;
#pragma unroll
            for (int ks = 0; ks < 8; ++ks) { const bf16x8 af = *(const LAS bf16x8*)(Cn + q * RSC + (16 * ks + 8 * hi) * 2);
#pragma unroll
                for (int pb = 0; pb < 2; ++pb) acc[pb] = MFMA32(pvf[ks][pb], af, acc[pb]); }
            const float aq = acs[e * 128 + q];
            { const float sc = __expf(aq);
#pragma unroll
              for (int i = 0; i < 16; ++i) { acc[0][i] *= sc; acc[1][i] *= sc; } }
            for (int ks = 0; ks <= 2 * qbk + 1; ++ks) {
                const int s0 = 16 * ks + 8 * hi;
                const u32x4 cw_ = *(const LAS u32x4*)(CBh + q * RSC + s0 * 2);
                const f32x4 a0 = *(const LAS f32x4*)(acs + e * 128 + s0), a1 = *(const LAS f32x4*)(acs + e * 128 + s0 + 4);
                const f32x4 d0 = *(const LAS f32x4*)(dtv + e * 128 + s0), d1 = *(const LAS f32x4*)(dtv + e * 128 + s0 + 4);
                const float cv[8] = {bflo(cw_.x), bfhi(cw_.x), bflo(cw_.y), bfhi(cw_.y), bflo(cw_.z), bfhi(cw_.z), bflo(cw_.w), bfhi(cw_.w)};
                float m[8];
#pragma unroll
                for (int j = 0; j < 4; ++j) { m[j] = (s0 + j <= q) ? cv[j] * __expf(aq - a0[j]) * d0[j] : 0.f; m[4 + j] = (s0 + 4 + j <= q) ? cv[4 + j] * __expf(aq - a1[j]) * d1[j] : 0.f; }
                u32x4 w; w.x = pk2(m[0], m[1]); w.y = pk2(m[2], m[3]); w.z = pk2(m[4], m[5]); w.w = pk2(m[6], m[7]);
                const bf16x8 af = __builtin_bit_cast(bf16x8, w);
#pragma unroll
                for (int pb = 0; pb < 2; ++pb) { lptr p = Xn + (16 * ks + 8 * hi) * RSX + (hl * 64 + 32 * pb) * 2 + tro_x; const bf16x8 xf = trfrag(p, p + 4 * RSX); acc[pb] = MFMA32(xf, af, acc[pb]); }
            }
#pragma unroll
            for (int pb = 0; pb < 2; ++pb)
#pragma unroll
                for (int gq = 0; gq < 4; ++gq) { const int pc = hl * 64 + 32 * pb + 8 * gq + 4 * hi;
                    const unsigned long long xw = *(const LAS unsigned long long*)(Xn + q * RSX + pc * 2);
                    const float y0 = acc[pb][4 * gq] + dsk * bflo((unsigned)xw), y1 = acc[pb][4 * gq + 1] + dsk * bfhi((unsigned)xw), y2 = acc[pb][4 * gq + 2] + dsk * bflo((unsigned)(xw >> 32)), y3 = acc[pb][4 * gq + 3] + dsk * bfhi((unsigned)(xw >> 32));
                    *(unsigned long long*)(Y + (row0 + q) * DIN + g * 512 + r * 256 + pc) = (unsigned long long)pk2(y0, y1) | ((unsigned long long)pk2(y2, y3) << 32); }
        }
    }
    __builtin_amdgcn_fence(__ATOMIC_RELEASE, "workgroup");
    __syncthreads();
    __builtin_amdgcn_fence(__ATOMIC_ACQUIRE, "workgroup");
    { const float* nw = a.in[8] + g * 512 + lane * 8; const f32x4 w0 = *(const f32x4*)nw, w1 = *(const f32x4*)(nw + 4);
      for (int t4 = wid * 16; t4 < wid * 16 + 16; t4 += 4) {
        u32x4 yv[4], zv[4];
#pragma unroll
        for (int k = 0; k < 4; ++k) { yv[k] = *(const u32x4*)(Y + (row0 + t4 + k) * DIN + g * 512 + lane * 8); zv[k] = *(const u32x4*)(srow + (size_t)(t4 + k) * NPROJ + OFF_Z + g * 512 + lane * 8); }
#pragma unroll
        for (int k = 0; k < 4; ++k) {
            float f[8] = {bflo(yv[k].x), bfhi(yv[k].x), bflo(yv[k].y), bfhi(yv[k].y), bflo(yv[k].z), bfhi(yv[k].z), bflo(yv[k].w), bfhi(yv[k].w)};
            const float zz[8] = {bflo(zv[k].x), bfhi(zv[k].x), bflo(zv[k].y), bfhi(zv[k].y), bflo(zv[k].z), bfhi(zv[k].z), bflo(zv[k].w), bfhi(zv[k].w)};
            float ss = 0.f;
#pragma unroll
            for (int j = 0; j < 8; ++j) { f[j] *= siluf_(zz[j]); ss += f[j] * f[j]; }
            const float rn = __builtin_amdgcn_rsqf(wave_sum(ss) * (1.0f / 512.0f) + EPS);
            u32x4 o; o.x = pk2(f[0] * rn * w0.x, f[1] * rn * w0.y); o.y = pk2(f[2] * rn * w0.z, f[3] * rn * w0.w); o.z = pk2(f[4] * rn * w1.x, f[5] * rn * w1.y); o.w = pk2(f[6] * rn * w1.z, f[7] * rn * w1.w);
            *(u32x4*)(Y + (row0 + t4 + k) * DIN + g * 512 + lane * 8) = o; }
      } }
    __syncthreads();
}

DI void ffn_fixup(const Args& a) {
    bf16_t* H = (bf16_t*)(a.ws + WS_H);
    const float* SBHA = (const float*)(a.ws + WS_SB); const float* SBHG = (const float*)(a.ws + WS_SB + SB_STRIDE); const float* SBT = (const float*)(a.ws + WS_SB + 2 * SB_STRIDE);
    const float* cw = a.in[17]; const float* cb = a.in[18];
    constexpr int NC4 = FFN / 4, NIT = (MTOK / 64) * 2 * NC4;
    for (int it = blockIdx.x * NTHR + threadIdx.x; it < NIT; it += gridDim.x * NTHR) {
        const int c4 = it % NC4, rr = it / NC4, fr = rr & 1, blk = rr >> 1, col = c4 * 4, row = blk * 64 + fr;
        const bool first = ((blk * 64) & (SEQ - 1)) == 0;
        const f32x4 zero = {0.f, 0.f, 0.f, 0.f};
        const f32x4 av = *(const f32x4*)(SBHA + ((size_t)blk * 2 + fr) * FFN + col), gv = *(const f32x4*)(SBHG + ((size_t)blk * 2 + fr) * FFN + col);
        const f32x4 t0 = first ? zero : *(const f32x4*)(SBT + ((size_t)(blk - 1) * 2 + 0) * FFN + col), t1 = first ? zero : *(const f32x4*)(SBT + ((size_t)(blk - 1) * 2 + 1) * FFN + col);
        const f32x4 h0 = *(const f32x4*)(SBHA + ((size_t)blk * 2 + 0) * FFN + col);
        const f32x4 a1 = fr == 1 ? h0 : t1, a2 = fr == 1 ? t1 : t0;
        const f32x4 w0 = *(const f32x4*)(cw + col), w1 = *(const f32x4*)(cw + FFN + col), w2 = *(const f32x4*)(cw + 2 * FFN + col), bs = *(const f32x4*)(cb + col);
        float hv[4];
#pragma unroll
        for (int k = 0; k < 4; ++k) { const float v = bs[k] + w0[k] * a2[k] + w1[k] * a1[k] + w2[k] * av[k]; hv[k] = siluf_(v) * gv[k]; }
        *(unsigned long long*)(H + (size_t)row * FFN + col) = (unsigned long long)pk2(hv[0], hv[1]) | ((unsigned long long)pk2(hv[2], hv[3]) << 32);
    }
}

typedef __attribute__((address_space(1))) unsigned gu32;
#define XB_TMO      128
#define XB_XCNT(j)  (256  + 64 * (j))
#define XB_XSUB(j)  (1280 + 64 * (j))
#define XB_XGEN(j)  (2304 + 64 * (j))
#define XB_TOP      3328
#define XB_TOPGEN   3392
#define XCD_BAR_WORDS 3456
#define XB_SPIN_CAP (1u << 18)

__device__ __forceinline__ unsigned xb_ld(unsigned* p)              { return __hip_atomic_load(p, __ATOMIC_RELAXED, __HIP_MEMORY_SCOPE_AGENT); }
__device__ __forceinline__ unsigned xb_add(unsigned* p, unsigned v) { return __hip_atomic_fetch_add(p, v, __ATOMIC_RELAXED, __HIP_MEMORY_SCOPE_AGENT); }
__device__ __forceinline__ unsigned xb_xcc_id() { return (unsigned)__builtin_amdgcn_s_getreg((3 << 11) | 20) & 0xFu; }
#define XB_SPIN(cond, bar) do { unsigned _sp = 0; while (cond) { __builtin_amdgcn_s_sleep(1); \
    if ((++_sp & 255u) == 0u) { if (xb_ld(&(bar)[XB_TMO])) break; if (_sp > XB_SPIN_CAP) { atomicAdd(&(bar)[XB_TMO], 1u); break; } } } } while (0)

struct XcdBarrier {
    unsigned* bar; unsigned x;
    volatile LAS unsigned* st;
};

__device__ __forceinline__ XcdBarrier xcd_barrier_post(unsigned* bar, volatile LAS unsigned* st) {
    XcdBarrier b; b.bar = bar; b.x = xb_xcc_id(); b.st = st;
    if (threadIdx.x == 0) (void)xb_add(&bar[XB_XCNT(b.x)], 1u);
    return b;
}
__device__ __forceinline__ void xcd_barrier_complete(unsigned* bar, unsigned x, unsigned& nloc, unsigned& nx) {
    const unsigned G = gridDim.x * gridDim.y * gridDim.z;
    unsigned sum, cnt, mine, sp = 0u;
    for (;;) {
        sum = 0u; cnt = 0u; mine = 0u;
#pragma unroll
        for (unsigned j = 0; j < 16; ++j) { const unsigned c = xb_ld(&bar[XB_XCNT(j)]); sum += c; cnt += (c > 0u) ? 1u : 0u; mine = (j == x) ? c : mine; }
        if (sum == G) break;
        __builtin_amdgcn_s_sleep(1);
        if ((++sp & 255u) == 0u) { if (xb_ld(&bar[XB_TMO])) break; if (sp > XB_SPIN_CAP) { atomicAdd(&bar[XB_TMO], 1u); break; } }
    }
    nloc = mine > 0u ? mine : 1u; nx = cnt > 0u ? cnt : 1u;
}

__device__ __forceinline__ void xcd_barrier(const XcdBarrier& b) {
    asm volatile("s_waitcnt vmcnt(0)" ::: "memory");
    __syncthreads();
    if (threadIdx.x == 0) {
        unsigned* bar = b.bar;
        __builtin_amdgcn_s_waitcnt(0);
        unsigned nloc = b.st[0], nx = b.st[1];
        if (nloc == 0u) { xcd_barrier_complete(bar, b.x, nloc, nx); b.st[0] = nloc; b.st[1] = nx; }
        const unsigned old = xb_add(&bar[XB_XSUB(b.x)], 1u);
        const unsigned gen = old / nloc;
        if (old + 1u == (gen + 1u) * nloc) {
            __builtin_amdgcn_fence(__ATOMIC_RELEASE, "agent");
            asm volatile("s_waitcnt vmcnt(0)" ::: "memory");
            const unsigned og = xb_add(&bar[XB_TOP], 1u);
            const unsigned tg = og / nx;
            if (og + 1u == (tg + 1u) * nx) xb_add(&bar[XB_TOPGEN], 1u);
            else XB_SPIN(xb_ld(&bar[XB_TOPGEN]) == tg, bar);
            __builtin_amdgcn_fence(__ATOMIC_ACQUIRE, "agent");
            xb_add(&bar[XB_XGEN(b.x)], 1u);
            asm volatile("s_waitcnt vmcnt(0)" ::: "memory");
        } else {
            XB_SPIN(xb_ld(&bar[XB_XGEN(b.x)]) == gen, bar);
            __builtin_amdgcn_fence(__ATOMIC_ACQUIRE, "agent");
            asm volatile("s_waitcnt vmcnt(0)" ::: "memory");
        }
    }
    __syncthreads();
}

#ifndef GALIGN
#define GALIGN true
#endif
#ifndef GSP2
#define GSP2 true
#endif
#ifndef PHMASK
#define PHMASK 0x3ff
#endif
#ifndef PHREP
#define PHREP 0
#endif
__global__ void __launch_bounds__(NTHR, 2) mk_fwd(Args args) {
    extern __shared__ __attribute__((aligned(16))) unsigned char lds_raw[];
    lptr lds = (lptr)lds_raw;
    const int G = gridDim.x, bx = blockIdx.x;
    const int vcu = (G % 8 == 0) ? (bx % 8) * (G / 8) + bx / 8 : bx;
    unsigned char* ws = args.ws;
    const int lo = args.ph_lo, hi = args.ph_hi;
    volatile LAS unsigned* bst = (volatile LAS unsigned*)(lds + LDS_BYTES - 16);
    if (threadIdx.x < 4) bst[threadIdx.x] = 0u;
    __syncthreads();
    XcdBarrier bar; bar.bar = (unsigned*)(ws + WS_CTL + CTL_BAR); bar.x = 0; bar.st = bst;
    if (hi - lo > 1) bar = xcd_barrier_post((unsigned*)(ws + WS_CTL + CTL_BAR), bst);
    if (hi < 0) cg::this_grid().sync();
#define IN(k) (((PHMASK >> (k)) & 1) && lo <= (k) && (k) < hi)
#define SEAM(k) do { if (IN(k) && IN((k) + 1)) xcd_barrier(bar); } while (0)
#define REP(k) for (int rp_ = 0; rp_ < ((((PHREP) >> (k)) & 1) ? 2 : 1); ++rp_)
#define REPSYNC() do { if (rp_) xcd_barrier(bar); } while (0)
#ifdef NSYNC
    for (int i_ = 0; i_ < NSYNC; ++i_) xcd_barrier(bar);
#endif
    REP(0) { REPSYNC(); if (IN(0)) { p0_prologue(args, lds, vcu, G); __syncthreads(); } }
    SEAM(0);
#ifndef STAGGER_TICKS
#define STAGGER_TICKS 0
#endif
#define RUN_P1() do { if (IN(1)) { \
        if (STAGGER_TICKS) { const unsigned long long t0_ = __builtin_amdgcn_s_memrealtime(), dl_ = (unsigned long long)bar.x * STAGGER_TICKS; while (__builtin_amdgcn_s_memrealtime() - t0_ < dl_) __builtin_amdgcn_s_sleep(8); } \
        pg8::Gemm g{(const bf16_t*)(ws + WS_U), (const bf16_t*)(ws + WS_WIN), MTOK, OFF_DT, DM}; pg8::StaticOrder S; S.init(MTOK, OFF_DT, G, bx); \
        pg8::Epi<0> E{(bf16_t*)(ws + WS_PROJ), nullptr, nullptr, nullptr, nullptr, nullptr, NPROJ, 0, 0}; \
        pg8::gemm_phase<pg8::Epi<0>, pg8::StaticOrder, GALIGN, GSP2>(lds, g, S, E); \
        dt_gemm(args, lds, vcu, G); } } while (0)
    RUN_P1();
#if (PHREP >> 1) & 1
    xcd_barrier(bar); RUN_P1();
#endif
    SEAM(1);
    if (IN(2)) {
        const bool s1first = (bx >> 3) & 1;
        if (s1first) { for (int u = vcu; u < 512; u += G) ssd_states_unit(args, lds, u >> 8, (u >> 3) & 31, u & 7); }
        for (int v = vcu; v < 256; v += G) { const int bh = v >> 3, s = v & 7;
            attn_unit(args, lds, bh >> 4, bh & 15, 15 - s); attn_unit(args, lds, bh >> 4, bh & 15, s); }
        if (!s1first) { for (int u = vcu; u < 512; u += G) ssd_states_unit(args, lds, u >> 8, (u >> 3) & 31, u & 7); }
    }
    SEAM(2);
    if (IN(3)) ssd_scan(args);
    SEAM(3);
    if (IN(4)) { for (int u = vcu; u < 512; u += G) ssd_out_unit(args, lds, u >> 8, (u >> 3) & 31, u & 7); }
#if (PHREP >> 4) & 1
    xcd_barrier(bar); if (IN(4)) { for (int u = vcu; u < 512; u += G) ssd_out_unit(args, lds, u >> 8, (u >> 3) & 31, u & 7); }
#endif
    SEAM(4);
#define RUN_P5() do { if (IN(5)) { \
        { pg8::Gemm g{(const bf16_t*)(ws + WS_Y), (const bf16_t*)(ws + WS_WSSM), MTOK, DM, DIN}; pg8::StaticOrder S; S.init(MTOK, DM, G, bx); \
          pg8::Epi<1> E{nullptr, args.out, nullptr, (const bf16_t*)(ws + WS_PROJ), args.in[11], nullptr, DM, NPROJ, OFF_G}; \
          pg8::gemm_phase<pg8::Epi<1>, pg8::StaticOrder, GALIGN, GSP2>(lds, g, S, E); } \
        __syncthreads(); \
        { pg8::Gemm g{(const bf16_t*)(ws + WS_U), (const bf16_t*)(ws + WS_WATT), MTOK, DM, DM}; pg8::StaticOrder S; S.init(MTOK, DM, G, bx); \
          pg8::Epi<2> E{(bf16_t*)(ws + WS_MIX), args.out, nullptr, (const bf16_t*)(ws + WS_PROJ), args.in[11] + DM, nullptr, DM, NPROJ, OFF_G + DM}; \
          pg8::gemm_phase<pg8::Epi<2>, pg8::StaticOrder, GALIGN, GSP2>(lds, g, S, E); } } } while (0)
    RUN_P5();
#if (PHREP >> 5) & 1
    xcd_barrier(bar); RUN_P5();
#endif
    SEAM(5);
    if (IN(6)) {
        pg8::Gemm g{(const bf16_t*)(ws + WS_MIX), (const bf16_t*)(ws + WS_WO), MTOK, DM, DM}; pg8::StaticOrder S; S.init(MTOK, DM, G, bx);
        pg8::Epi<3> E{(bf16_t*)(ws + WS_U), args.out, args.in[0], nullptr, args.in[15], (float*)(ws + WS_CTL + CTL_ROWSS), DM, 0, 0};
        pg8::gemm_phase<pg8::Epi<3>, pg8::StaticOrder, GALIGN, GSP2>(lds, g, S, E);
    }
    SEAM(6);
#define RUN_P7() do { if (IN(7)) { \
        pg8::Gemm g{(const bf16_t*)(ws + WS_U), (const bf16_t*)(ws + WS_WUP), MTOK, NUP, DM}; pg8::StaticOrder S; S.init(MTOK, NUP, G, bx); \
        pg8::EpiFfn E{(bf16_t*)(ws + WS_H), (const float*)(ws + WS_CTL + CTL_ROWSS), args.in[17], args.in[18], (float*)(ws + WS_SB), (float*)(ws + WS_SB + SB_STRIDE), (float*)(ws + WS_SB + 2 * SB_STRIDE)}; \
        pg8::gemm_phase<pg8::EpiFfn, pg8::StaticOrder, GALIGN, GSP2>(lds, g, S, E); \
        { const int nwg_ = (MTOK / 256) * (NUP / 256), rem_ = nwg_ % G, nidle_ = rem_ ? G - rem_ : G, first_ = rem_ ? rem_ : 0;     \
          if (bx >= first_) wdn_convert(args, lds, (bx - first_) * NWAVES + (int)(threadIdx.x >> 6), nidle_ * NWAVES); } } } while (0)
    RUN_P7();
#if (PHREP >> 7) & 1
    xcd_barrier(bar); RUN_P7();
#endif
    SEAM(7);
    REP(8) { REPSYNC(); if (IN(8)) ffn_fixup(args); }
    SEAM(8);
    if (IN(9)) {
        pg8::Gemm g{(const bf16_t*)(ws + WS_H), (const bf16_t*)(ws + WS_WDN), MTOK, DM, FFN}; pg8::StaticOrder S; S.init(MTOK, DM, G, bx);
        pg8::Epi<5> E{nullptr, args.out, nullptr, nullptr, nullptr, nullptr, DM, 0, 0};
        pg8::gemm_phase<pg8::Epi<5>, pg8::StaticOrder, GALIGN, GSP2>(lds, g, S, E);
    }
#undef IN
#undef SEAM
}

extern "C" void kernel_launch(void* const* d_in, const int* in_sizes, int n_in, void* d_out, int out_size, void* d_ws, size_t ws_size, hipStream_t stream) {
    static int grid = 0;
    if (grid == 0) {
        if (n_in != 20 || out_size != MTOK * DM || ws_size < WS_END) { fprintf(stderr, "kernel_launch: unexpected shapes (n_in %d out %d ws %zu)\n", n_in, out_size, ws_size); grid = -1; return; }
        int dev = 0, cus = 0, per_cu = 0;
        hipGetDevice(&dev); hipDeviceGetAttribute(&cus, hipDeviceAttributeMultiprocessorCount, dev);
        if (hipFuncSetAttribute((const void*)mk_fwd, hipFuncAttributeMaxDynamicSharedMemorySize, LDS_BYTES) != hipSuccess) { fprintf(stderr, "kernel_launch: hipFuncSetAttribute failed\n"); grid = -1; return; }
        if (hipOccupancyMaxActiveBlocksPerMultiprocessor(&per_cu, (const void*)mk_fwd, NTHR, LDS_BYTES) != hipSuccess || per_cu < 1) { fprintf(stderr, "kernel_launch: occupancy query says %d\n", per_cu); per_cu = 1; }
        (void)hipGetLastError();
        grid = cus * 1;
        fprintf(stderr, "kernel_launch: grid %d (cus %d, per_cu %d)\n", grid, cus, per_cu);
    }
    if (grid < 0) return;
    Args a{};
    for (int i = 0; i < 20; ++i) a.in[i] = (const float*)d_in[i];
    a.out = (float*)d_out; a.ws = (unsigned char*)d_ws;
#if MK_N_LAUNCHES == 1
    if (hipMemsetAsync((char*)d_ws + WS_CTL + CTL_BAR, 0, CTL_BAR_BYTES, stream) != hipSuccess) { fprintf(stderr, "kernel_launch: memset of the barrier words failed\n"); return; }
#ifdef XMEMSET
    for (int i_ = 0; i_ < XMEMSET; ++i_) (void)hipMemsetAsync((char*)d_ws + WS_CTL + CTL_BAR + CTL_BAR_BYTES * (1 + i_), 0, CTL_BAR_BYTES, stream);
#endif
    a.ph_lo = 0; a.ph_hi = 10;
    void* kargs[] = {&a};
    hipError_t e = hipLaunchCooperativeKernel((const void*)mk_fwd, dim3(grid), dim3(NTHR), kargs, LDS_BYTES, stream);
    if (e != hipSuccess) fprintf(stderr, "kernel_launch: cooperative launch failed: %s\n", hipGetErrorString(e));
#else
    for (int ph = 0; ph < 10; ++ph) { a.ph_lo = ph; a.ph_hi = ph + 1; hipLaunchKernelGGL(mk_fwd, dim3(grid), dim3(NTHR), LDS_BYTES, stream, a); }
#endif
}
```

```cpp
#include <hip/hip_runtime.h>
#include <hip/hip_cooperative_groups.h>
#include <cstdio>
#include <cstdint>
namespace cg = cooperative_groups;
#ifndef MK_N_LAUNCHES
#define MK_N_LAUNCHES 1
#endif
#include <hip/hip_runtime.h>
#include <cstdio>
#include <cstdint>
namespace pg8 {
#define PG8_LAS __attribute__((address_space(3)))
typedef unsigned short bf16_t;
typedef short bf16x8 __attribute__((ext_vector_type(8)));
typedef float f32x4 __attribute__((ext_vector_type(4)));
typedef unsigned u32x4 __attribute__((ext_vector_type(4)));
constexpr int BM = 256, BK = 64, HALF = 128, HTB = HALF * BK * 2  , STAGE_BYTES = 8 * HTB, NXCD = 8, WGM = 8;

__host__ __device__ __forceinline__ int lds_byte(int r, int c) { const int st = (r >> 4) * 2 + (c >> 5), rr = r & 15, cc = c & 31, ob = rr * 64 + cc * 2; return st * 1024 + (ob ^ (((ob >> 9) & 1) << 5)); }
__host__ __device__ __forceinline__ void stage_rc(int b, int& R, int& C) { const int st = b / 1024, sb = b % 1024, swz = sb ^ (((sb >> 9) & 1) << 5); R = (st >> 1) * 16 + swz / 64; C = (st & 1) * 32 + (swz % 64) / 2; }
__host__ __device__ __forceinline__ int perm32(int rho) { const int n = rho >> 4, i = rho & 15; return 8 * (i >> 2) + 4 * n + (i & 3); }

struct Unit { int pm, pn; };
struct Gemm { const bf16_t* A; const bf16_t* Bt; int M, N, K; };

struct StaticOrder {
    int nM, nN, nwg, G, c;
    __host__ __device__ void init(int M, int N, int G_, int c_) { nM = M / BM; nN = N / BM; nwg = nM * nN; G = G_; c = c_; }
    __host__ __device__ bool next(int i, Unit& u) const {
        const long L = (long)i * G + c; if (L >= nwg) return false;
        int wgid = (int)L; { const int q = nwg / NXCD, r = nwg % NXCD, xcd = wgid % NXCD, off = wgid / NXCD; wgid = (xcd < r ? xcd * (q + 1) : r * (q + 1) + (xcd - r) * q) + off; }
        const int nig = WGM * nN, gid = wgid / nig, fm = gid * WGM, gsz = (nM - fm) < WGM ? (nM - fm) : WGM;
        u.pm = fm + ((wgid % nig) % gsz); u.pn = (wgid % nig) / gsz; return true;
    }
    __device__ __forceinline__ void a_ready(const Unit&) const {}
    __device__ __forceinline__ void done(const Unit&) const {}
};

typedef float f32x2 __attribute__((ext_vector_type(2)));
typedef __bf16 bf16x2v __attribute__((ext_vector_type(2)));
__device__ __forceinline__ unsigned cvt_pk_bf16(float lo, float hi) { f32x2 v = {lo, hi}; bf16x2v b = __builtin_convertvector(v, bf16x2v); return __builtin_bit_cast(unsigned, b); }
__device__ __forceinline__ float bflo(unsigned w) { return __uint_as_float(w << 16); }
__device__ __forceinline__ float bfhi(unsigned w) { return __uint_as_float(w & 0xffff0000u); }
__device__ __forceinline__ float sigmoidf_(float v) { return __builtin_amdgcn_rcpf(1.0f + __expf(-v)); }
template <int MODE> struct Epi {
    static constexpr bool PERM = true, AFTER_DRAIN = false;
    bf16_t* O; float* T1; const float* X0; const bf16_t* G; const float* gb; float* rowss; int ldc, ldg, gcol0;
    __device__ __forceinline__ void operator()(const f32x4 (&acc)[2][2][4][2], const Unit& u, int wr, int wc, int fr, int fq) const {
        const int row0 = u.pm * BM + wr * 64 + fr, col0 = u.pn * BM + wc * 32 + 8 * fq;
        f32x4 cb_[2][2];
        if (MODE == 1 || MODE == 2 || MODE == 3) {
#pragma unroll
            for (int bj = 0; bj < 2; ++bj) { cb_[bj][0] = *(const f32x4*)(gb + col0 + bj * HALF); cb_[bj][1] = *(const f32x4*)(gb + col0 + bj * HALF + 4); } }
#pragma unroll
        for (int ai = 0; ai < 2; ++ai) {
            u32x4 pg[4][2], pt[4][2]; f32x4 px[4][2][2]; float prs[4];
#pragma unroll
            for (int m = 0; m < 4; ++m) {
                const int row = row0 + ai * HALF + m * 16;
                if (MODE == 4) prs[m] = rowss[row];
#pragma unroll
                for (int bj = 0; bj < 2; ++bj) { const int col = col0 + bj * HALF; const size_t off = (size_t)row * ldc + col;
                    if (MODE == 1 || MODE == 2) pg[m][bj] = *(const u32x4*)(G + (size_t)row * ldg + gcol0 + col);
                    if (MODE == 2) pt[m][bj] = *(const u32x4*)((const bf16_t*)T1 + off);
                    if (MODE == 3) { px[m][bj][0] = *(const f32x4*)(X0 + off); px[m][bj][1] = *(const f32x4*)(X0 + off + 4); }
                    if (MODE == 5) { px[m][bj][0] = *(const f32x4*)(T1 + off); px[m][bj][1] = *(const f32x4*)(T1 + off + 4); } }
            }
#pragma unroll
            for (int m = 0; m < 4; ++m) {
                const int row = row0 + ai * HALF + m * 16;
                float rs = 1.f, ssq = 0.f;
                if (MODE == 4) rs = __builtin_amdgcn_rsqf(prs[m] * (1.0f / 2048.0f) + 1e-6f);
#pragma unroll
                for (int bj = 0; bj < 2; ++bj) {
                    const int col = col0 + bj * HALF; const size_t off = (size_t)row * ldc + col;
                    f32x4 v0 = acc[ai][bj][m][0], v1 = acc[ai][bj][m][1];
                    if (MODE == 1 || MODE == 2) {
                        const u32x4 gw = pg[m][bj]; const f32x4 b0 = cb_[bj][0], b1 = cb_[bj][1];
                        f32x4 s0, s1;
                        s0[0] = sigmoidf_(bflo(gw[0]) + b0[0]); s0[1] = sigmoidf_(bfhi(gw[0]) + b0[1]); s0[2] = sigmoidf_(bflo(gw[1]) + b0[2]); s0[3] = sigmoidf_(bfhi(gw[1]) + b0[3]);
                        s1[0] = sigmoidf_(bflo(gw[2]) + b1[0]); s1[1] = sigmoidf_(bfhi(gw[2]) + b1[1]); s1[2] = sigmoidf_(bflo(gw[3]) + b1[2]); s1[3] = sigmoidf_(bfhi(gw[3]) + b1[3]);
                        v0 = v0 * s0; v1 = v1 * s1;
                        if (MODE == 1) { u32x4 w; w.x = cvt_pk_bf16(v0[0], v0[1]); w.y = cvt_pk_bf16(v0[2], v0[3]); w.z = cvt_pk_bf16(v1[0], v1[1]); w.w = cvt_pk_bf16(v1[2], v1[3]); *(u32x4*)((bf16_t*)T1 + off) = w; }
                        else { const u32x4 t = pt[m][bj];
                            v0[0] += bflo(t.x); v0[1] += bfhi(t.x); v0[2] += bflo(t.y); v0[3] += bfhi(t.y); v1[0] += bflo(t.z); v1[1] += bfhi(t.z); v1[2] += bflo(t.w); v1[3] += bfhi(t.w); }
                    }
                    if (MODE == 3) {
                        v0 = v0 + px[m][bj][0]; v1 = v1 + px[m][bj][1];
                        *(f32x4*)(T1 + off) = v0; *(f32x4*)(T1 + off + 4) = v1;
                        ssq += (v0[0] * v0[0] + v0[1] * v0[1]) + (v0[2] * v0[2] + v0[3] * v0[3]) + (v1[0] * v1[0] + v1[1] * v1[1]) + (v1[2] * v1[2] + v1[3] * v1[3]);
                        v0 = v0 * cb_[bj][0]; v1 = v1 * cb_[bj][1];
                    }
                    if (MODE == 4) { v0 = v0 * rs; v1 = v1 * rs; }
                    if (MODE == 5) {
                        v0 = v0 + px[m][bj][0]; v1 = v1 + px[m][bj][1];
                        *(f32x4*)(T1 + off) = v0; *(f32x4*)(T1 + off + 4) = v1;
                    }
                    if (MODE == 0 || MODE == 2 || MODE == 3 || MODE == 4) {
                        u32x4 w; w.x = cvt_pk_bf16(v0[0], v0[1]); w.y = cvt_pk_bf16(v0[2], v0[3]); w.z = cvt_pk_bf16(v1[0], v1[1]); w.w = cvt_pk_bf16(v1[2], v1[3]);
                        *(u32x4*)(O + off) = w;
                    }
                }
                if (MODE == 3) { ssq += __shfl_xor(ssq, 16); ssq += __shfl_xor(ssq, 32); if (fq == 0) atomicAdd(rowss + row, ssq); }
            }
        }
    }
};

__device__ __forceinline__ float dpp_ror1(float v) { return __builtin_bit_cast(float, __builtin_amdgcn_update_dpp(0, __builtin_bit_cast(int, v), 0x121, 0xf, 0xf, false)); }
__device__ __forceinline__ float dpp_ror2(float v) { return __builtin_bit_cast(float, __builtin_amdgcn_update_dpp(0, __builtin_bit_cast(int, v), 0x122, 0xf, 0xf, false)); }
struct EpiFfn {
    static constexpr bool PERM = true, AFTER_DRAIN = false;
    bf16_t* H; const float* rowss; const float* cw; const float* cb; float* SBHA; float* SBHG; float* SBT;
    __device__ __forceinline__ void operator()(const f32x4 (&acc)[2][2][4][2], const Unit& u, int wr, int wc, int fr, int fq) const {
        constexpr int F = 5632;
        const int j0 = u.pn * HALF + wc * 32 + 8 * fq;
        float w0[8], w1[8], w2[8], bs[8];
#pragma unroll
        for (int h = 0; h < 2; ++h) { const f32x4 a = *(const f32x4*)(cw + j0 + 4 * h), b = *(const f32x4*)(cw + F + j0 + 4 * h), c = *(const f32x4*)(cw + 2 * F + j0 + 4 * h), d = *(const f32x4*)(cb + j0 + 4 * h);
#pragma unroll
            for (int k = 0; k < 4; ++k) { w0[4 * h + k] = a[k]; w1[4 * h + k] = b[k]; w2[4 * h + k] = c[k]; bs[4 * h + k] = d[k]; } }
#pragma unroll
        for (int ai = 0; ai < 2; ++ai) {
            const int R0 = u.pm * BM + ai * HALF + wr * 64, blk = R0 >> 6;
            float ap[8];
#pragma unroll
            for (int k = 0; k < 8; ++k) ap[k] = 0.f;
#pragma unroll
            for (int m = 0; m < 4; ++m) {
                const int row = R0 + 16 * m + fr;
                const float rs = __builtin_amdgcn_rsqf(rowss[row] * (1.0f / 2048.0f) + 1e-6f);
                float av[8], gv[8], hv[8];
#pragma unroll
                for (int k = 0; k < 4; ++k) { av[k] = acc[ai][0][m][0][k] * rs; av[4 + k] = acc[ai][0][m][1][k] * rs; gv[k] = acc[ai][1][m][0][k] * rs; gv[4 + k] = acc[ai][1][m][1][k] * rs; }
#pragma unroll
                for (int k = 0; k < 8; ++k) {
                    const float s1 = dpp_ror1(av[k]), s2 = dpp_ror2(av[k]), p1 = dpp_ror1(ap[k]), p2 = dpp_ror2(ap[k]);
                    const float a1 = fr >= 1 ? s1 : p1, a2 = fr >= 2 ? s2 : p2;
                    const float v = bs[k] + w0[k] * a2 + w1[k] * a1 + w2[k] * av[k];
                    hv[k] = v * __builtin_amdgcn_rcpf(1.0f + __expf(-v)) * gv[k];
                }
                if (m > 0 || fr >= 2) {
                    u32x4 w; w.x = cvt_pk_bf16(hv[0], hv[1]); w.y = cvt_pk_bf16(hv[2], hv[3]); w.z = cvt_pk_bf16(hv[4], hv[5]); w.w = cvt_pk_bf16(hv[6], hv[7]);
                    *(u32x4*)(H + (size_t)row * F + j0) = w;
                } else {
                    const size_t o = ((size_t)blk * 2 + fr) * F + j0;
                    *(f32x4*)(SBHA + o) = (f32x4){av[0], av[1], av[2], av[3]}; *(f32x4*)(SBHA + o + 4) = (f32x4){av[4], av[5], av[6], av[7]};
                    *(f32x4*)(SBHG + o) = (f32x4){gv[0], gv[1], gv[2], gv[3]}; *(f32x4*)(SBHG + o + 4) = (f32x4){gv[4], gv[5], gv[6], gv[7]};
                }
                if (m == 3 && fr >= 14) {
                    const size_t o = ((size_t)blk * 2 + (fr - 14)) * F + j0;
                    *(f32x4*)(SBT + o) = (f32x4){av[0], av[1], av[2], av[3]}; *(f32x4*)(SBT + o + 4) = (f32x4){av[4], av[5], av[6], av[7]};
                }
#pragma unroll
                for (int k = 0; k < 8; ++k) ap[k] = av[k];
            }
        }
    }
};

template <class Epi, class Sched, bool ALIGN_EPI = false, bool SP2 = false>
__device__ __forceinline__ void gemm_phase(PG8_LAS unsigned char* lds, const Gemm g, const Sched& S, const Epi& E) {
    const int tid = threadIdx.x, wid = __builtin_amdgcn_readfirstlane(tid >> 6), lane = tid & 63, wr = wid >> 2, wc = wid & 3, fr = lane & 15, fq = lane >> 4;
    const int K = g.K, nt = K / BK;
    unsigned voffA[2], voffB[2];
#pragma unroll
    for (int i = 0; i < 2; ++i) { int R, C; stage_rc(tid * 16 + i * 8192, R, C); const int Rb = Epi::PERM ? ((R & ~31) + perm32(R & 31)) : R;
        voffA[i] = (unsigned)(R * K + C) * 2u; voffB[i] = (unsigned)(Rb * K + C) * 2u; }
    const size_t kstep = (size_t)(BK * 2);
    const size_t hstep = (size_t)HALF * K * 2;
    const size_t tstep = 2 * hstep;
    const unsigned ldsw = (unsigned)wid * 1024u;
    const int aoff = lds_byte(wr * 64 + fr, fq * 8), boff = lds_byte(wc * 32 + fr, fq * 8);
#define PG8_SA(b, h) (((b) * 2 + (h)) * HTB)
#define PG8_SB(b, h) ((4 + (b) * 2 + (h)) * HTB)
#define PG8_STAGE(bufoff, gbase, voff) do { _Pragma("unroll") for (int _i = 0; _i < 2; ++_i) \
        __builtin_amdgcn_global_load_lds((const unsigned*)((const char*)(gbase) + (voff)[_i]), (PG8_LAS unsigned*)(lds + (bufoff) + ldsw + _i * 8192), 16, 0, 0); } while (0)
#define PG8_LDA(dst, b, h) do { _Pragma("unroll") for (int m = 0; m < 4; ++m) _Pragma("unroll") for (int k = 0; k < 2; ++k) dst[m][k] = *(const PG8_LAS bf16x8*)(lds + PG8_SA(b, h) + aoff + m * 2048 + k * 1024); } while (0)
#define PG8_LDB(dst, b, h) do { _Pragma("unroll") for (int n = 0; n < 2; ++n) _Pragma("unroll") for (int k = 0; k < 2; ++k) dst[n][k] = *(const PG8_LAS bf16x8*)(lds + PG8_SB(b, h) + boff + n * 2048 + k * 1024); } while (0)
#define PG8_MMA(ai, bj, At, Bt) do { __builtin_amdgcn_s_setprio(1); _Pragma("unroll") for (int m = 0; m < 4; ++m) _Pragma("unroll") for (int n = 0; n < 2; ++n) _Pragma("unroll") for (int k = 0; k < 2; ++k) \
        acc[ai][bj][m][n] = __builtin_amdgcn_mfma_f32_16x16x32_bf16(Bt[n][k], At[m][k], acc[ai][bj][m][n], 0, 0, 0); __builtin_amdgcn_s_setprio(0); } while (0)
#define PG8_WAIT_V(n) asm volatile("s_waitcnt vmcnt(" #n ")" ::: "memory")
#define PG8_WAIT_L(n) asm volatile("s_waitcnt lgkmcnt(" #n ")" ::: "memory")
#define PG8_BAR __builtin_amdgcn_s_barrier()
#define PG8_SCHED __builtin_amdgcn_sched_barrier(0)
    Unit cur, nxt; int ui = 0;
    if (!S.next(0, cur)) return;
    f32x4 acc[2][2][4][2];
#pragma unroll
    for (int a = 0; a < 2; ++a)
#pragma unroll
        for (int b = 0; b < 2; ++b)
#pragma unroll
            for (int m = 0; m < 4; ++m)
#pragma unroll
                for (int n = 0; n < 2; ++n) acc[a][b][m][n] = (f32x4){0.f, 0.f, 0.f, 0.f};
    bf16x8 At[4][2], B0[2][2], B1[2][2];
    const char* cA = (const char*)g.A + (size_t)cur.pm * tstep; const char* cB = (const char*)g.Bt + (size_t)cur.pn * tstep;
    S.a_ready(cur);
    if constexpr (SP2) {
        PG8_STAGE(PG8_SB(0, 0), cB, voffB); PG8_STAGE(PG8_SB(0, 1), cB + hstep, voffB); PG8_STAGE(PG8_SA(0, 0), cA, voffA); PG8_STAGE(PG8_SA(0, 1), cA + hstep, voffA);
        if (wr == 1) PG8_BAR;
        PG8_WAIT_V(2); PG8_BAR;
        PG8_STAGE(PG8_SB(1, 0), cB + kstep, voffB); PG8_STAGE(PG8_SA(1, 0), cA + kstep, voffA); PG8_STAGE(PG8_SB(1, 1), cB + hstep + kstep, voffB);
        PG8_WAIT_V(6); PG8_BAR;
    } else {
        PG8_STAGE(PG8_SB(0, 0), cB, voffB); PG8_STAGE(PG8_SA(0, 0), cA, voffA); PG8_STAGE(PG8_SB(0, 1), cB + hstep, voffB); PG8_STAGE(PG8_SA(0, 1), cA + hstep, voffA);
        if (wr == 1) PG8_BAR;
        PG8_WAIT_V(4); PG8_BAR;
        PG8_STAGE(PG8_SB(1, 0), cB + kstep, voffB); PG8_STAGE(PG8_SA(1, 0), cA + kstep, voffA); PG8_STAGE(PG8_SB(1, 1), cB + hstep + kstep, voffB);
        PG8_WAIT_V(6); PG8_BAR;
    }
    for (;;) {
        const bool has_next = S.next(ui + 1, nxt);
        const char* nA = has_next ? (const char*)g.A + (size_t)nxt.pm * tstep : cA; const char* nB = has_next ? (const char*)g.Bt + (size_t)nxt.pn * tstep : cB;
        for (int t = 0; t < nt; t += 2) {
            const bool last = (t == nt - 2);
            const char* a1 = cA + (size_t)(t + 1) * kstep;
            const char* a2 = last ? nA : cA + (size_t)(t + 2) * kstep; const char* b2 = last ? nB : cB + (size_t)(t + 2) * kstep;
            const char* a3 = a2 + kstep; const char* b3 = b2 + kstep;
            if (last && has_next) S.a_ready(nxt);
            if constexpr (SP2) {
            PG8_LDB(B0, 0, 0); PG8_LDB(B1, 0, 1); PG8_SCHED; PG8_LDA(At, 0, 0); PG8_STAGE(PG8_SA(1, 1), a1 + hstep, voffA);
            PG8_WAIT_V(8); PG8_WAIT_L(0); PG8_BAR; PG8_MMA(0, 0, At, B0); PG8_MMA(0, 1, At, B1); PG8_BAR; PG8_SCHED;
            PG8_LDA(At, 0, 1); PG8_STAGE(PG8_SB(0, 0), b2, voffB); PG8_STAGE(PG8_SB(0, 1), b2 + hstep, voffB); PG8_STAGE(PG8_SA(0, 0), a2, voffA);
            PG8_WAIT_V(8); PG8_WAIT_L(0); PG8_BAR; PG8_MMA(1, 0, At, B0); PG8_MMA(1, 1, At, B1); PG8_BAR; PG8_SCHED;
            PG8_LDB(B0, 1, 0); PG8_LDB(B1, 1, 1); PG8_SCHED; PG8_LDA(At, 1, 0); PG8_STAGE(PG8_SA(0, 1), a2 + hstep, voffA);
            PG8_WAIT_V(8); PG8_WAIT_L(0); PG8_BAR; PG8_MMA(0, 0, At, B0); PG8_MMA(0, 1, At, B1); PG8_BAR; PG8_SCHED;
            PG8_LDA(At, 1, 1); PG8_STAGE(PG8_SB(1, 0), b3, voffB); PG8_STAGE(PG8_SB(1, 1), b3 + hstep, voffB); PG8_STAGE(PG8_SA(1, 0), a3, voffA);
            PG8_WAIT_V(8); PG8_WAIT_L(0); PG8_BAR; PG8_MMA(1, 0, At, B0); PG8_MMA(1, 1, At, B1); PG8_BAR; PG8_SCHED;
            } else {
            PG8_LDB(B0, 0, 0); PG8_SCHED; PG8_LDA(At, 0, 0); PG8_STAGE(PG8_SA(1, 1), a1 + hstep, voffA);
            PG8_WAIT_L(8); PG8_BAR; PG8_WAIT_L(0); PG8_MMA(0, 0, At, B0); PG8_BAR; PG8_SCHED;
            PG8_LDB(B1, 0, 1); PG8_STAGE(PG8_SB(0, 0), b2, voffB);
            PG8_BAR; PG8_WAIT_L(0); PG8_MMA(0, 1, At, B1); PG8_BAR;
            PG8_LDA(At, 0, 1); PG8_STAGE(PG8_SA(0, 0), a2, voffA);
            PG8_BAR; PG8_WAIT_L(0); PG8_MMA(1, 0, At, B0); PG8_BAR; PG8_SCHED;
            PG8_STAGE(PG8_SB(0, 1), b2 + hstep, voffB);
            PG8_WAIT_V(6); PG8_BAR; PG8_MMA(1, 1, At, B1); PG8_BAR;
            PG8_LDB(B0, 1, 0); PG8_SCHED; PG8_LDA(At, 1, 0); PG8_STAGE(PG8_SA(0, 1), a2 + hstep, voffA);
            PG8_WAIT_L(8); PG8_BAR; PG8_WAIT_L(0); PG8_MMA(0, 0, At, B0); PG8_BAR; PG8_SCHED;
            PG8_LDB(B1, 1, 1); PG8_STAGE(PG8_SB(1, 0), b3, voffB);
            PG8_BAR; PG8_WAIT_L(0); PG8_MMA(0, 1, At, B1); PG8_BAR;
            PG8_LDA(At, 1, 1); PG8_STAGE(PG8_SA(1, 0), a3, voffA);
            PG8_BAR; PG8_WAIT_L(0); PG8_MMA(1, 0, At, B0); PG8_BAR; PG8_SCHED;
            PG8_STAGE(PG8_SB(1, 1), b3 + hstep, voffB);
            PG8_WAIT_V(6); PG8_BAR; PG8_MMA(1, 1, At, B1); PG8_BAR;
            }
        }
        if constexpr (ALIGN_EPI) { if (wr == 0) PG8_BAR; }
        if constexpr (!Epi::AFTER_DRAIN) { E(acc, cur, wr, wc, fr, fq); S.done(cur); }
        if (!has_next) break;
#pragma unroll
        for (int a = 0; a < 2; ++a)
#pragma unroll
            for (int b = 0; b < 2; ++b)
#pragma unroll
                for (int m = 0; m < 4; ++m)
#pragma unroll
                    for (int n = 0; n < 2; ++n) acc[a][b][m][n] = (f32x4){0.f, 0.f, 0.f, 0.f};
        cur = nxt; cA = nA; cB = nB; ++ui;
        if constexpr (ALIGN_EPI) { if (wr == 1) PG8_BAR; }
    }
    PG8_WAIT_V(0);
    if constexpr (!ALIGN_EPI) { if (wr == 0) PG8_BAR; }
    PG8_BAR;
    if constexpr (Epi::AFTER_DRAIN) { E.fused(acc, cur, wr, wc, fr, fq, lds, wid, lane); S.done(cur); }
#undef PG8_SA
#undef PG8_SB
#undef PG8_STAGE
#undef PG8_LDA
#undef PG8_LDB
#undef PG8_MMA
#undef PG8_WAIT_V
#undef PG8_WAIT_L
#undef PG8_BAR
#undef PG8_SCHED
}
}

#define DI __device__ __forceinline__
#define LAS __attribute__((address_space(3)))
typedef unsigned short bf16_t;
typedef short bf16x8 __attribute__((ext_vector_type(8)));
typedef short s16x4 __attribute__((ext_vector_type(4)));
typedef float f32x4 __attribute__((ext_vector_type(4)));
typedef float f32x16 __attribute__((ext_vector_type(16)));
typedef unsigned u32x4 __attribute__((ext_vector_type(4)));
typedef LAS unsigned char* lptr;
constexpr int NTHR = 512, NWAVES = 8;
constexpr int BATCH = 2, SEQ = 4096, DM = 2048, MTOK = BATCH * SEQ;
constexpr int DIN = 4096, NPROJ = 20736;
constexpr int OFF_Z = 0, OFF_XBC = 4096, OFF_Q = 10240, OFF_K = 12288, OFF_V = 14336, OFF_G = 16384, OFF_DT = 20480;
constexpr int FFN = 5632, NUP = 2 * FFN;
constexpr float EPS = 1e-6f;
constexpr size_t MiB = 1u << 20;
constexpr size_t WS_CTL = 0, WS_WIN = 1 * MiB, WS_WSSM = 82 * MiB, WS_WATT = 98 * MiB, WS_WO = 106 * MiB, WS_WUP = 114 * MiB, WS_WDN = 158 * MiB,
                 WS_U = 180 * MiB, WS_Y = 212 * MiB, WS_PROJ = 276 * MiB, WS_SB = 600 * MiB  , WS_DT = 618 * MiB  , WS_END = 620 * MiB;
constexpr size_t WS_ST = WS_WIN  , WS_MIX = WS_WIN  , WS_H = WS_PROJ  ;
constexpr size_t SB_STRIDE = (size_t)(MTOK / 64) * 2 * FFN * 4;
constexpr size_t CTL_ROWSS = 0, CTL_CD = 65536, CTL_BAR = 131072, CTL_BAR_BYTES = 16384;
constexpr int LDS_BYTES = 150 * 1024;

DI unsigned pk2(float lo, float hi) { return pg8::cvt_pk_bf16(lo, hi); }
DI float bflo(unsigned w) { return __uint_as_float(w << 16); }
DI float bfhi(unsigned w) { return __uint_as_float(w & 0xffff0000u); }
DI float bf1(bf16_t h) { return __uint_as_float((unsigned)h << 16); }
DI float wave_sum(float v) {
#pragma unroll
    for (int o = 1; o < 64; o <<= 1) v += __shfl_xor(v, o);
    return v;
}
DI float siluf_(float v) { return v * __builtin_amdgcn_rcpf(1.0f + __expf(-v)); }
DI float softplusf_(float v) { return fmaxf(v, 0.f) + log1pf(__expf(-fabsf(v))); }
#define MFMA32(a, b, c) __builtin_amdgcn_mfma_f32_32x32x16_bf16((a), (b), (c), 0, 0, 0)
DI int crow(int r, int hi) { return (r & 3) + 8 * (r >> 2) + 4 * hi; }
typedef short v4i16_t __attribute__((ext_vector_type(4)));
DI s16x4 trread(lptr p) { return __builtin_bit_cast(s16x4, __builtin_amdgcn_ds_read_tr16_b64_v4i16((LAS v4i16_t*)p)); }
DI bf16x8 trfrag(lptr plo, lptr phi) { const s16x4 a = trread(plo), b = trread(phi); return __builtin_shufflevector(a, b, 0, 1, 2, 3, 4, 5, 6, 7); }
DI int tr_off(int lane, int rs) { const int i = lane & 15; return (i >> 2) * rs + (((lane >> 4) & 1) * 16 + (i & 3) * 4) * 2; }

struct Args { const float* in[20]; float* out; unsigned char* ws; int ph_lo, ph_hi; };

struct TrItem { const float* src; bf16_t* dst; int K, N; };
DI TrItem p0_decode(const Args& a, int it) {
    constexpr int I_IN = (DM / 64) * (20544 / 64), I_SSM = (DIN / 64) * (DM / 64), I_ATT = (DM / 64) * (DM / 64), I_O = I_ATT, I_UP = (DM / 64) * (NUP / 64);
    const float* W; bf16_t* WT; int K, N, map = 0, r = it; unsigned char* ws = a.ws;
    if (r < I_IN) { W = a.in[2]; WT = (bf16_t*)(ws + WS_WIN); K = DM; N = 20544; map = 1; }
    else if ((r -= I_IN) < I_SSM) { W = a.in[12]; WT = (bf16_t*)(ws + WS_WSSM); K = DIN; N = DM; }
    else if ((r -= I_SSM) < I_ATT) { W = a.in[13]; WT = (bf16_t*)(ws + WS_WATT); K = DM; N = DM; }
    else if ((r -= I_ATT) < I_O) { W = a.in[14]; WT = (bf16_t*)(ws + WS_WO); K = DM; N = DM; }
    else if ((r -= I_O) < I_UP) { W = a.in[16]; WT = (bf16_t*)(ws + WS_WUP); K = DM; N = NUP; map = 2; }
    else { r -= I_UP; W = a.in[19]; WT = (bf16_t*)(ws + WS_WDN); K = FFN; N = DM; }
    const int nblk = N / 64, kb = r / nblk, nb = r % nblk, k0 = 64 * kb, n0 = 64 * nb;
    int d0 = n0;
    if (map == 1) { if (n0 >= 10304) d0 = n0 - 64; else if (n0 >= 10240) d0 = OFF_DT + (n0 - 10240); }
    if (map == 2) { const int g_ = n0 >= FFN, n1 = n0 - g_ * FFN; d0 = 256 * (n1 >> 7) + 128 * g_ + (n1 & 127); }
    TrItem t; t.src = W + (size_t)k0 * N + n0; t.dst = WT + (size_t)d0 * K + k0; t.K = K; t.N = N; return t;
}
DI void p0_tr_load(f32x4 (&v)[16], const TrItem& t, int lane) {
    const int c = lane & 15, rsub = lane >> 4;
#pragma unroll
    for (int i = 0; i < 16; ++i) v[i] = __builtin_nontemporal_load((const f32x4*)(t.src + (size_t)(4 * i + rsub) * t.N + 4 * c));
}
DI void p0_tr_store(const f32x4 (&v)[16], const TrItem& t, LAS float* scr, int lane) {
    const int c = lane & 15, rsub = lane >> 4;
#pragma unroll
    for (int i = 0; i < 16; ++i) { LAS float* d = scr + (4 * i + rsub) * 65 + 4 * c; d[0] = v[i].x; d[1] = v[i].y; d[2] = v[i].z; d[3] = v[i].w; }
    asm volatile("s_waitcnt lgkmcnt(0)" ::: "memory");
    const int kc = lane & 7, nsub = lane >> 3;
#pragma unroll
    for (int j = 0; j < 8; ++j) { const int n = nsub + 8 * j; const LAS float* s = scr + (8 * kc) * 65 + n;
        u32x4 o; o.x = pk2(s[0 * 65], s[1 * 65]); o.y = pk2(s[2 * 65], s[3 * 65]); o.z = pk2(s[4 * 65], s[5 * 65]); o.w = pk2(s[6 * 65], s[7 * 65]);
        *(u32x4*)(t.dst + (size_t)n * t.K + 8 * kc) = o; }
    asm volatile("s_waitcnt lgkmcnt(0)" ::: "memory");
}
DI void wdn_convert(const Args& a, lptr lds, int widx, int nw) {
    const int lane = threadIdx.x & 63, wave = threadIdx.x >> 6;
    LAS float* scr = (LAS float*)(lds + wave * 16640);
    constexpr int NB = DM / 64, NIT = (FFN / 64) * NB;
    f32x4 v[16];
    for (int it = widx; it < NIT; it += nw) {
        const int kb = it / NB, nb = it % NB;
        TrItem t; t.src = a.in[19] + (size_t)(64 * kb) * DM + 64 * nb; t.dst = (bf16_t*)(a.ws + WS_WDN) + (size_t)(64 * nb) * FFN + 64 * kb; t.K = FFN; t.N = DM;
        p0_tr_load(v, t, lane);
        p0_tr_store(v, t, scr, lane);
    }
}
DI void p0_prologue(const Args& a, lptr lds, int vcu, int G) {
    const int tid = threadIdx.x, lane = tid & 63, wave = tid >> 6;
    unsigned char* ws = a.ws;
    LAS float* scr = (LAS float*)(lds + wave * 16640);
    const int gw = vcu * NWAVES + wave, NGW = G * NWAVES;
    const int gt = blockIdx.x * NTHR + tid, NGT = G * NTHR;
    for (int i = gt; i < MTOK; i += NGT) ((float*)(ws + WS_CTL + CTL_ROWSS))[i] = 0.f;
    constexpr int NITEMS = (DM / 64) * (20544 / 64) + (DIN / 64) * (DM / 64) + 2 * (DM / 64) * (DM / 64) + (DM / 64) * (NUP / 64);
    if (gw < NITEMS) {
        f32x4 va[16], vb[16];
        TrItem ta = p0_decode(a, gw), tb = ta;
        p0_tr_load(va, ta, lane);
        for (int it = gw; it < NITEMS; it += 2 * NGW) {
            const bool hb = it + NGW < NITEMS;
            if (hb) { tb = p0_decode(a, it + NGW); p0_tr_load(vb, tb, lane); }
            p0_tr_store(va, ta, scr, lane);
            if (!hb) break;
            const bool ha = it + 2 * NGW < NITEMS;
            if (ha) { ta = p0_decode(a, it + 2 * NGW); p0_tr_load(va, ta, lane); }
            p0_tr_store(vb, tb, scr, lane);
            if (!ha) break;
        }
    }
    const float* x = a.in[0]; const float* nw = a.in[1]; bf16_t* U = (bf16_t*)(ws + WS_U);
    for (int m = gw; m < MTOK; m += NGW) {
        const f32x4* xr = (const f32x4*)(x + (size_t)m * DM) + lane;
        f32x4 v[8]; float s = 0.f;
#pragma unroll
        for (int j = 0; j < 8; ++j) { v[j] = __builtin_nontemporal_load(xr + 64 * j); s += (v[j].x * v[j].x + v[j].y * v[j].y) + (v[j].z * v[j].z + v[j].w * v[j].w); }
        const float r = __builtin_amdgcn_rsqf(wave_sum(s) * (1.0f / DM) + EPS);
        unsigned long long* o8 = (unsigned long long*)(U + (size_t)m * DM) + lane;
#pragma unroll
        for (int j = 0; j < 8; ++j) { const f32x4 w = ((const f32x4*)nw)[64 * j + lane];
            o8[64 * j] = (unsigned long long)pk2(v[j].x * r * w.x, v[j].y * r * w.y) | ((unsigned long long)pk2(v[j].z * r * w.z, v[j].w * r * w.w) << 32); }
    }
}

DI void dt_gemm(const Args& a, lptr lds, int vcu, int G) {
    const int tid = threadIdx.x, lane = tid & 63, wid = __builtin_amdgcn_readfirstlane(tid >> 6), r32 = lane & 31, hi = lane >> 5;
    const bf16_t* U = (const bf16_t*)(a.ws + WS_U); const bf16_t* Wd = (const bf16_t*)(a.ws + WS_WIN) + (size_t)OFF_DT * DM;
    float* DT = (float*)(a.ws + WS_DT);
    LAS float* red = (LAS float*)lds;
    for (int rb = vcu; rb < MTOK / 32; rb += G) {
        const int kbase = wid * 256 + 8 * hi;
        f32x16 acc[2];
#pragma unroll
        for (int nb = 0; nb < 2; ++nb)
#pragma unroll
            for (int k = 0; k < 16; ++k) acc[nb][k] = 0.f;
        const bf16_t* ap = U + (size_t)(rb * 32 + r32) * DM + kbase; const bf16_t* bp = Wd + (size_t)r32 * DM + kbase;
#pragma unroll 4
        for (int ks = 0; ks < 16; ++ks) { const bf16x8 af = *(const bf16x8*)(ap + 16 * ks), b0 = *(const bf16x8*)(bp + 16 * ks), b1 = *(const bf16x8*)(bp + (size_t)32 * DM + 16 * ks);
            acc[0] = MFMA32(af, b0, acc[0]); acc[1] = MFMA32(af, b1, acc[1]); }
#pragma unroll
        for (int nb = 0; nb < 2; ++nb)
#pragma unroll
            for (int i = 0; i < 16; ++i) red[(wid * 2 + nb) * 1024 + crow(i, hi) * 32 + r32] = acc[nb][i];
        __syncthreads();
        for (int o = tid; o < 2048; o += NTHR) { const int nb = o >> 10, rem = o & 1023; float sacc = 0.f;
#pragma unroll
            for (int w = 0; w < 8; ++w) sacc += red[(w * 2 + nb) * 1024 + rem];
            DT[(size_t)(rb * 32 + (rem >> 5)) * 64 + nb * 32 + (rem & 31)] = sacc; }
        __syncthreads();
    }
}

template <int NT> DI void conv_load(u32x4 (&raw)[NT + 3], const bf16_t* srow, int seq0, int col, int t0) {
#pragma unroll
    for (int i = 0; i < NT + 3; ++i) { const int t = t0 - 3 + i; const bool ok = (seq0 + t) >= 0; raw[i] = *(const u32x4*)(srow + (ptrdiff_t)(ok ? t : 0) * NPROJ + col); if (!ok) raw[i] = (u32x4){0u, 0u, 0u, 0u}; }
}
template <int NT> DI void conv_compute(const u32x4 (&raw)[NT + 3], int col, const float* cw, const float* cb, int t0, lptr dst, int rs, int dbyte, const LAS float* scale) {
    const int ch = col - OFF_XBC;
    float w[4][8], bs[8], h0[8], h1[8], h2[8];
#pragma unroll
    for (int k = 0; k < 4; ++k) { const f32x4 a = *(const f32x4*)(cw + (size_t)k * 6144 + ch), b = *(const f32x4*)(cw + (size_t)k * 6144 + ch + 4);
        w[k][0] = a.x; w[k][1] = a.y; w[k][2] = a.z; w[k][3] = a.w; w[k][4] = b.x; w[k][5] = b.y; w[k][6] = b.z; w[k][7] = b.w; }
    { const f32x4 a = *(const f32x4*)(cb + ch), b = *(const f32x4*)(cb + ch + 4); bs[0] = a.x; bs[1] = a.y; bs[2] = a.z; bs[3] = a.w; bs[4] = b.x; bs[5] = b.y; bs[6] = b.z; bs[7] = b.w; }
#define CV_UNPACK(dstv, r_) do { dstv[0] = bflo(r_.x); dstv[1] = bfhi(r_.x); dstv[2] = bflo(r_.y); dstv[3] = bfhi(r_.y); dstv[4] = bflo(r_.z); dstv[5] = bfhi(r_.z); dstv[6] = bflo(r_.w); dstv[7] = bfhi(r_.w); } while (0)
    CV_UNPACK(h0, raw[0]); CV_UNPACK(h1, raw[1]); CV_UNPACK(h2, raw[2]);
#pragma unroll
    for (int tt = 0; tt < NT; ++tt) {
        float cur[8], y[8]; CV_UNPACK(cur, raw[3 + tt]);
        const float sc = scale ? scale[t0 + tt] : 1.0f;
#pragma unroll
        for (int j = 0; j < 8; ++j) { const float v = bs[j] + w[0][j] * h0[j] + w[1][j] * h1[j] + w[2][j] * h2[j] + w[3][j] * cur[j]; y[j] = siluf_(v) * sc; h0[j] = h1[j]; h1[j] = h2[j]; h2[j] = cur[j]; }
        u32x4 o; o.x = pk2(y[0], y[1]); o.y = pk2(y[2], y[3]); o.z = pk2(y[4], y[5]); o.w = pk2(y[6], y[7]);
        *(LAS u32x4*)(dst + (t0 + tt) * rs + dbyte) = o;
    }
#undef CV_UNPACK
}

DI void ssd_dt(const Args& a, const float* dtrow, int g, LAS float* dtv, LAS float* acs, float* cd_out) {
    const int lane = threadIdx.x & 63, e = threadIdx.x >> 6, head = g * 8 + e;
    const float bias = a.in[5][head], A = -__expf(a.in[6][head]);
    const float d0 = softplusf_(dtrow[(2 * lane) * 64 + head] + bias), d1 = softplusf_(dtrow[(2 * lane + 1) * 64 + head] + bias);
    const float a0 = d0 * A, a1 = d1 * A; float inc = a0 + a1;
#pragma unroll
    for (int o = 1; o < 64; o <<= 1) { const float t = __shfl_up(inc, o); if (lane >= o) inc += t; }
    dtv[e * 128 + 2 * lane] = d0; dtv[e * 128 + 2 * lane + 1] = d1;
    acs[e * 128 + 2 * lane] = inc - a1; acs[e * 128 + 2 * lane + 1] = inc;
    if (cd_out && lane == 63) cd_out[head] = __expf(inc);
}

DI void ssd_states_unit(const Args& a, lptr lds, int b, int c, int g) {
    int tid_ = threadIdx.x; asm volatile("" : "+v"(tid_));
    const int tid = tid_, lane = tid & 63, wid = __builtin_amdgcn_readfirstlane(tid >> 6), r32 = lane & 31, hi = lane >> 5;
    const bf16_t* proj = (const bf16_t*)(a.ws + WS_PROJ);
    const bf16_t* srow = proj + (size_t)(b * SEQ + c * 128) * NPROJ;
    const int seq0 = c * 128;
    constexpr int RSB = 288, RSX = 544;
    lptr Bn = lds, Xn = lds + 128 * RSB; LAS float* dtv = (LAS float*)(lds + 128 * RSB + 128 * RSX); LAS float* acs = dtv + 1024; LAS float* wsc = acs + 1024;
    float* cd = (float*)(a.ws + WS_CTL + CTL_CD) + (size_t)(b * 32 + c) * 64;
    const int bcol = OFF_XBC + DIN + g * 128 + (tid & 15) * 8, xcc = tid & 31, xtg = tid >> 5;
    u32x4 rawB[11], rawX[11];
    if (tid < 256) conv_load<8>(rawB, srow, seq0, bcol, (tid >> 4) * 8);
    conv_load<8>(rawX, srow, seq0, OFF_XBC + g * 512 + xcc * 8, xtg * 8);
    ssd_dt(a, (const float*)(a.ws + WS_DT) + (size_t)(b * SEQ + c * 128) * 64, g, dtv, acs, cd);
    __syncthreads();
    for (int i = tid; i < 1024; i += NTHR) { const int e = i >> 7; wsc[i] = dtv[i] * __expf(acs[e * 128 + 127] - acs[i]); }
    if (tid < 256) conv_compute<8>(rawB, bcol, a.in[3], a.in[4], (tid >> 4) * 8, Bn, RSB, (tid & 15) * 16, nullptr);
    bf16_t* ST = (bf16_t*)(a.ws + WS_ST) + (size_t)((b * 32 + c) * 64 + g * 8) * 8192;
    const int tro_b = tr_off(lane, RSB), tro_x = tr_off(lane, RSX);
    for (int r = 0; r < 2; ++r) {
        __syncthreads();
        conv_compute<8>(rawX, OFF_XBC + g * 512 + r * 256 + xcc * 8, a.in[3], a.in[4], xtg * 8, Xn, RSX, xcc * 16, wsc + (r * 4 + (xcc >> 3)) * 128);
        __syncthreads();
        if (r == 0) conv_load<8>(rawX, srow, seq0, OFF_XBC + g * 512 + 256 + xcc * 8, xtg * 8);
        const int hl = wid >> 1, nh = wid & 1;
        f32x16 acc[2][2];
#pragma unroll
        for (int i = 0; i < 2; ++i)
#pragma unroll
            for (int j = 0; j < 2; ++j)
#pragma unroll
                for (int k = 0; k < 16; ++k) acc[i][j][k] = 0.f;
#pragma unroll 2
        for (int ks = 0; ks < 8; ++ks) {
            const int krow = 16 * ks + 8 * hi;
            bf16x8 af[2], bfr[2];
#pragma unroll
            for (int pb = 0; pb < 2; ++pb) { lptr p = Xn + krow * RSX + (hl * 64 + 32 * pb) * 2 + tro_x; af[pb] = trfrag(p, p + 4 * RSX); }
#pragma unroll
            for (int nb = 0; nb < 2; ++nb) { lptr p = Bn + krow * RSB + (64 * nh + 32 * nb) * 2 + tro_b; bfr[nb] = trfrag(p, p + 4 * RSB); }
#pragma unroll
            for (int pb = 0; pb < 2; ++pb)
#pragma unroll
                for (int nb = 0; nb < 2; ++nb) acc[pb][nb] = MFMA32(bfr[nb], af[pb], acc[pb][nb]);
        }
        bf16_t* dst = ST + (size_t)(r * 4 + hl) * 8192;
#pragma unroll
        for (int pb = 0; pb < 2; ++pb)
#pragma unroll
            for (int nb = 0; nb < 2; ++nb)
#pragma unroll
                for (int gq = 0; gq < 4; ++gq) { const unsigned long long w = (unsigned long long)pk2(acc[pb][nb][4 * gq], acc[pb][nb][4 * gq + 1]) | ((unsigned long long)pk2(acc[pb][nb][4 * gq + 2], acc[pb][nb][4 * gq + 3]) << 32);
                    *(unsigned long long*)(dst + (32 * pb + r32) * 128 + 64 * nh + 32 * nb + 8 * gq + 4 * hi) = w; }
    }
    __syncthreads();
}

DI void attn_unit(const Args& a, lptr lds, int b, int h, int qb) {
    int tid_ = threadIdx.x; asm volatile("" : "+v"(tid_));
    const int tid = tid_, lane = tid & 63, wid = __builtin_amdgcn_readfirstlane(tid >> 6), r32 = lane & 31, hi = lane >> 5;
    const bf16_t* proj = (const bf16_t*)(a.ws + WS_PROJ);
    bf16_t* att = (bf16_t*)(a.ws + WS_U);
    const size_t rowbase = (size_t)b * SEQ; const int q0 = qb * 256;
    constexpr int RSK = 272, RSV = 288;
    lptr Qs = lds, Ks = lds, Vs = lds + 64 * RSK;
    const int dc = tid & 15, rsub = tid >> 4;
    float wn[8];
    { const f32x4 w0 = *(const f32x4*)(a.in[9] + dc * 8), w1 = *(const f32x4*)(a.in[9] + dc * 8 + 4); const float sc = 0.08838834764831845f * 1.4426950408889634f;
      wn[0] = w0.x * sc; wn[1] = w0.y * sc; wn[2] = w0.z * sc; wn[3] = w0.w * sc; wn[4] = w1.x * sc; wn[5] = w1.y * sc; wn[6] = w1.z * sc; wn[7] = w1.w * sc; }
#pragma unroll 2
    for (int i = 0; i < 8; ++i) { const int row = rsub + 32 * i;
        const u32x4 r_ = *(const u32x4*)(proj + (rowbase + q0 + row) * NPROJ + OFF_Q + h * 128 + dc * 8);
        float f[8] = {bflo(r_.x), bfhi(r_.x), bflo(r_.y), bfhi(r_.y), bflo(r_.z), bfhi(r_.z), bflo(r_.w), bfhi(r_.w)};
        float ss = 0.f;
#pragma unroll
        for (int j = 0; j < 8; ++j) ss += f[j] * f[j];
        ss += __shfl_xor(ss, 1); ss += __shfl_xor(ss, 2); ss += __shfl_xor(ss, 4); ss += __shfl_xor(ss, 8);
        const float rn = __builtin_amdgcn_rsqf(ss * (1.0f / 128.0f) + EPS);
        u32x4 o; o.x = pk2(f[0] * rn * wn[0], f[1] * rn * wn[1]); o.y = pk2(f[2] * rn * wn[2], f[3] * rn * wn[3]); o.z = pk2(f[4] * rn * wn[4], f[5] * rn * wn[5]); o.w = pk2(f[6] * rn * wn[6], f[7] * rn * wn[7]);
        *(LAS u32x4*)(Qs + row * RSK + dc * 16) = o; }
    __syncthreads();
    bf16x8 qf[8];
#pragma unroll
    for (int ds = 0; ds < 8; ++ds) qf[ds] = *(const LAS bf16x8*)(Qs + (wid * 32 + r32) * RSK + (16 * ds + 8 * hi) * 2);
    __syncthreads();
    { const f32x4 w0 = *(const f32x4*)(a.in[10] + dc * 8), w1 = *(const f32x4*)(a.in[10] + dc * 8 + 4);
      wn[0] = w0.x; wn[1] = w0.y; wn[2] = w0.z; wn[3] = w0.w; wn[4] = w1.x; wn[5] = w1.y; wn[6] = w1.z; wn[7] = w1.w; }
    f32x16 o[4];
#pragma unroll
    for (int d0 = 0; d0 < 4; ++d0)
#pragma unroll
        for (int k = 0; k < 16; ++k) o[d0][k] = 0.f;
    float R = 0.f;
    LAS int* flags = (LAS int*)(lds + 256 * RSK);
    if (lane == 0) flags[wid] = 0;
    bool mydone = false;
    const int qw0 = q0 + wid * 32, qpos = qw0 + r32;
    const int ntiles = (q0 + 256) / 64;
    const bf16_t* kvbase = proj + rowbase * NPROJ + h * 128 + dc * 8;
    u32x4 kreg[2], vreg[2];
#define AT_PREFETCH(kt) do { _Pragma("unroll") for (int i_ = 0; i_ < 2; ++i_) { const bf16_t* p_ = kvbase + (size_t)((kt) * 64 + rsub + 32 * i_) * NPROJ; \
        kreg[i_] = *(const u32x4*)(p_ + OFF_K); vreg[i_] = *(const u32x4*)(p_ + OFF_V); } } while (0)
    AT_PREFETCH(ntiles - 1);
    const int tro_v = tr_off(lane, RSV);
    for (int kt = ntiles - 1; kt >= 0; --kt) {
#pragma unroll
        for (int i = 0; i < 2; ++i) { const int key = rsub + 32 * i; const u32x4 r_ = kreg[i];
            float f[8] = {bflo(r_.x), bfhi(r_.x), bflo(r_.y), bfhi(r_.y), bflo(r_.z), bfhi(r_.z), bflo(r_.w), bfhi(r_.w)};
            float ss = 0.f;
#pragma unroll
            for (int j = 0; j < 8; ++j) ss += f[j] * f[j];
            ss += __shfl_xor(ss, 1); ss += __shfl_xor(ss, 2); ss += __shfl_xor(ss, 4); ss += __shfl_xor(ss, 8);
            const float rn = __builtin_amdgcn_rsqf(ss * (1.0f / 128.0f) + EPS);
            u32x4 w; w.x = pk2(f[0] * rn * wn[0], f[1] * rn * wn[1]); w.y = pk2(f[2] * rn * wn[2], f[3] * rn * wn[3]); w.z = pk2(f[4] * rn * wn[4], f[5] * rn * wn[5]); w.w = pk2(f[6] * rn * wn[6], f[7] * rn * wn[7]);
            *(LAS u32x4*)(Ks + key * RSK + dc * 16) = w;
            *(LAS u32x4*)(Vs + key * RSV + dc * 16) = vreg[i]; }
        __syncthreads();
        if (kt > 0) AT_PREFETCH(kt - 1);
        const int key0 = kt * 64;
        if (!mydone && key0 < qw0 + 31) {
#pragma unroll
            for (int blk = 1; blk >= 0; --blk) {
                const int kb0 = key0 + 32 * blk;
                if (kb0 < qw0 + 31) {
                    f32x16 z;
#pragma unroll
                    for (int k = 0; k < 16; ++k) z[k] = 0.f;
#pragma unroll
                    for (int ds = 0; ds < 8; ++ds) { const bf16x8 kf = *(const LAS bf16x8*)(Ks + (32 * blk + r32) * RSK + (16 * ds + 8 * hi) * 2); z = MFMA32(kf, qf[ds], z); }
                    float lk[16], lb[16];
#pragma unroll
                    for (int i = 0; i < 16; ++i) { const float zz = z[i]; const float l1p = __builtin_amdgcn_logf(1.0f + __builtin_amdgcn_exp2f(-fabsf(zz)));
                        const float lbv = fminf(zz, 0.f) - l1p, lkv = lbv - zz; const bool valid = (kb0 + crow(i, hi)) < qpos;
                        lk[i] = valid ? lkv : 0.f; lb[i] = valid ? lbv : -INFINITY; }
                    float suf[16], gs[4], pgs[4], aft[4];
#pragma unroll
                    for (int j = 0; j < 4; ++j) { suf[4 * j + 3] = 0.f; suf[4 * j + 2] = lk[4 * j + 3]; suf[4 * j + 1] = suf[4 * j + 2] + lk[4 * j + 2]; suf[4 * j] = suf[4 * j + 1] + lk[4 * j + 1]; gs[j] = suf[4 * j] + lk[4 * j]; }
#pragma unroll
                    for (int j = 0; j < 4; ++j) pgs[j] = __shfl_xor(gs[j], 32);
                    const float T0 = gs[0] + pgs[0], T1 = gs[1] + pgs[1], T2 = gs[2] + pgs[2], T3 = gs[3] + pgs[3];
                    const float SP2 = T3, SP1 = SP2 + T2, SP0 = SP1 + T1, total = SP0 + T0;
                    aft[3] = 0.f; aft[2] = SP2; aft[1] = SP1; aft[0] = SP0;
                    if (hi == 0) {
#pragma unroll
                        for (int j = 0; j < 4; ++j) aft[j] += pgs[j]; }
                    float p[16];
#pragma unroll
                    for (int i = 0; i < 16; ++i) p[i] = __builtin_amdgcn_exp2f(lb[i] + (R + aft[i >> 2] + suf[i]));
                    R += total;
                    bf16x8 pa[2];
#pragma unroll
                    for (int s = 0; s < 2; ++s) { u32x4 w; w.x = pk2(p[8 * s], p[8 * s + 1]); w.y = pk2(p[8 * s + 2], p[8 * s + 3]); w.z = pk2(p[8 * s + 4], p[8 * s + 5]); w.w = pk2(p[8 * s + 6], p[8 * s + 7]); pa[s] = __builtin_bit_cast(bf16x8, w); }
#pragma unroll
                    for (int s = 0; s < 2; ++s)
#pragma unroll
                        for (int d0 = 0; d0 < 4; ++d0) { lptr vp = Vs + (32 * blk + 16 * s + 4 * hi) * RSV + (32 * d0) * 2 + tro_v; const bf16x8 vf = trfrag(vp, vp + 8 * RSV); o[d0] = MFMA32(vf, pa[s], o[d0]); }
                }
            }
            mydone = __all(R < -150.1f);
            if (mydone && lane == 0) flags[wid] = 1;
        }
        __syncthreads();
        { int alld = 1;
#pragma unroll
          for (int w = 0; w < 8; ++w) alld &= flags[w];
          if (alld) break; }
    }
    __syncthreads();
#undef AT_PREFETCH
    bf16_t* orow = att + (rowbase + qw0 + r32) * DM + h * 128 + 4 * hi;
#pragma unroll
    for (int d0 = 0; d0 < 4; ++d0)
#pragma unroll
        for (int gq = 0; gq < 4; ++gq) { const unsigned long long w = (unsigned long long)pk2(o[d0][4 * gq], o[d0][4 * gq + 1]) | ((unsigned long long)pk2(o[d0][4 * gq + 2], o[d0][4 * gq + 3]) << 32);
            *(unsigned long long*)(orow + 32 * d0 + 8 * gq) = w; }
}

DI void ssd_scan(const Args& a) {
    bf16_t* ST = (bf16_t*)(a.ws + WS_ST); const float* cd = (const float*)(a.ws + WS_CTL + CTL_CD);
    const int NIT = BATCH * 64 * 8192 / 8;
    for (int it = blockIdx.x * NTHR + threadIdx.x; it < NIT; it += gridDim.x * NTHR) {
        const int b = it / (64 * 1024), rem = it % (64 * 1024), head = rem / 1024;
        float run[8];
#pragma unroll
        for (int j = 0; j < 8; ++j) run[j] = 0.f;
        u32x4* p = (u32x4*)(ST + (size_t)b * 32 * 64 * 8192 + (size_t)rem * 8);
        constexpr size_t CS = 64 * 8192 / 8;
#pragma unroll 1
        for (int c0 = 0; c0 < 32; c0 += 8) {
            u32x4 v[8]; float d[8];
#pragma unroll
            for (int k = 0; k < 8; ++k) { v[k] = p[(size_t)(c0 + k) * CS]; d[k] = cd[(b * 32 + c0 + k) * 64 + head]; }
#pragma unroll
            for (int k = 0; k < 8; ++k) {
                u32x4 o; o.x = pk2(run[0], run[1]); o.y = pk2(run[2], run[3]); o.z = pk2(run[4], run[5]); o.w = pk2(run[6], run[7]);
                const float dd = d[k]; const u32x4 vv = v[k];
                run[0] = run[0] * dd + bflo(vv.x); run[1] = run[1] * dd + bfhi(vv.x); run[2] = run[2] * dd + bflo(vv.y); run[3] = run[3] * dd + bfhi(vv.y);
                run[4] = run[4] * dd + bflo(vv.z); run[5] = run[5] * dd + bfhi(vv.z); run[6] = run[6] * dd + bflo(vv.w); run[7] = run[7] * dd + bfhi(vv.w);
                v[k] = o; }
#pragma unroll
            for (int k = 0; k < 8; ++k) p[(size_t)(c0 + k) * CS] = v[k];
        }
    }
}

DI void ssd_out_unit(const Args& a, lptr lds, int b, int c, int g) {
    int tid_ = threadIdx.x; asm volatile("" : "+v"(tid_));
    const int tid = tid_, lane = tid & 63, wid = __builtin_amdgcn_readfirstlane(tid >> 6), r32 = lane & 31, hi = lane >> 5;
    const bf16_t* proj = (const bf16_t*)(a.ws + WS_PROJ);
    const size_t row0 = (size_t)b * SEQ + c * 128;
    const bf16_t* srow = proj + row0 * NPROJ;
    const int seq0 = c * 128;
    constexpr int RSC = 272, RSX = 544;
    lptr Cn = lds, CBh = lds + 128 * RSC, Bn = CBh + 128 * RSC, Xn = Bn; LAS float* dtv = (LAS float*)(Bn + 128 * RSX); LAS float* acs = dtv + 1024;
    bf16_t* Y = (bf16_t*)(a.ws + WS_Y);
    const int cbcol = OFF_XBC + DIN + (tid < 256 ? 1024 : 0) + g * 128 + (tid & 15) * 8, cbt0 = ((tid & 255) >> 4) * 8;
    const int xcol = OFF_XBC + g * 512 + (tid & 31) * 8, xt0 = (tid >> 5) * 8;
#ifdef PROBE_P4
    const unsigned long long tp0_ = __builtin_amdgcn_s_memrealtime();
#endif
    u32x4 rawCB[11], rawX[11];
    conv_load<8>(rawCB, srow, seq0, cbcol, cbt0);
    conv_load<8>(rawX, srow, seq0, xcol, xt0);
    ssd_dt(a, (const float*)(a.ws + WS_DT) + row0 * 64, g, dtv, acs, nullptr);
    conv_compute<8>(rawCB, cbcol, a.in[3], a.in[4], cbt0, tid < 256 ? Cn : Bn, RSC, (tid & 15) * 16, nullptr);
    __syncthreads();
    for (int i = tid; i < 1024; i += NTHR) dtv[i] = dtv[i] * __expf(acs[(i & ~127) + (i & 120)] - acs[i]);
    { const int qbk = wid >> 1;
#pragma unroll
      for (int sbi = 0; sbi < 2; ++sbi) { const int sb = 2 * (wid & 1) + sbi;
        if (sb <= qbk) {
            f32x16 acc;
#pragma unroll
            for (int k = 0; k < 16; ++k) acc[k] = 0.f;
#pragma unroll
            for (int ks = 0; ks < 8; ++ks) { const bf16x8 af = *(const LAS bf16x8*)(Cn + (32 * qbk + r32) * RSC + (16 * ks + 8 * hi) * 2), bf_ = *(const LAS bf16x8*)(Bn + (32 * sb + r32) * RSC + (16 * ks + 8 * hi) * 2);
                acc = MFMA32(af, bf_, acc); }
#pragma unroll
            for (int i = 0; i < 16; ++i) *(LAS bf16_t*)(CBh + (32 * qbk + crow(i, hi)) * RSC + (32 * sb + r32) * 2) = (bf16_t)(pk2(acc[i], 0.f) & 0xffffu);
        } } }
#ifdef PROBE_P4
    __syncthreads(); const unsigned long long tp1_ = __builtin_amdgcn_s_memrealtime();
#endif
    const int tro_x = tr_off(lane, RSX);
    const bf16_t* PV = (const bf16_t*)(a.ws + WS_ST) + (size_t)((b * 32 + c) * 64 + g * 8) * 8192;
    for (int r = 0; r < 2; ++r) {
        const int hl = wid >> 1, e = 4 * r + hl, head = g * 8 + e, qp = (wid ^ (wid >> 2)) & 1;
        __syncthreads();
        const bf16_t* pv = PV + (size_t)e * 8192;
        bf16x8 pvf[8][2];
#pragma unroll
        for (int ks = 0; ks < 8; ++ks)
#pragma unroll
            for (int pb = 0; pb < 2; ++pb) pvf[ks][pb] = *(const bf16x8*)(pv + (32 * pb + r32) * 128 + 16 * ks + 8 * hi);
        conv_compute<8>(rawX, xcol + r * 256, a.in[3], a.in[4], xt0, Xn, RSX, (tid & 31) * 16, nullptr);
        __syncthreads();
        if (r == 0) conv_load<8>(rawX, srow, seq0, xcol + 256, xt0);
        const float dsk = a.in[7][head];
#pragma unroll 1
        for (int qs = 0; qs < 2; ++qs) {
            const int qbk = 2 * qp + qs, q = 32 * qbk + r32;
            f32x16 acc[2];
#pragma unroll
            for (int pb = 0; pb < 2; ++pb)
#pragma unroll
                for (int k = 0; k < 16; ++k) acc[pb][k] = 0.f;
#pragma unroll
            for (int ks = 0; ks < 8; ++ks) { const bf16x8 af = *(const LAS bf16x8*)(Cn + q * RSC + (16 * ks + 8 * hi) * 2);
#pragma unroll
                for (int pb = 0; pb < 2; ++pb) acc[pb] = MFMA32(pvf[ks][pb], af, acc[pb]); }
            const float aq = acs[e * 128 + q];
            { const float sc = __expf(aq);
#pragma unroll
              for (int i = 0; i < 16; ++i) { acc[0][i] *= sc; acc[1][i] *= sc; } }
            for (int ks = 0; ks <= 2 * qbk + 1; ++ks) {
                const int s0 = 16 * ks + 8 * hi;
                const u32x4 cw_ = *(const LAS u32x4*)(CBh + q * RSC + s0 * 2);
                const f32x4 d0 = *(const LAS f32x4*)(dtv + e * 128 + s0), d1 = *(const LAS f32x4*)(dtv + e * 128 + s0 + 4);
                const float e1 = __expf(aq - acs[e * 128 + s0]);
                const float cv[8] = {bflo(cw_.x), bfhi(cw_.x), bflo(cw_.y), bfhi(cw_.y), bflo(cw_.z), bfhi(cw_.z), bflo(cw_.w), bfhi(cw_.w)};
                float m[8];
#pragma unroll
                for (int j = 0; j < 4; ++j) { m[j] = (s0 + j <= q) ? cv[j] * d0[j] * e1 : 0.f; m[4 + j] = (s0 + 4 + j <= q) ? cv[4 + j] * d1[j] * e1 : 0.f; }
                u32x4 w; w.x = pk2(m[0], m[1]); w.y = pk2(m[2], m[3]); w.z = pk2(m[4], m[5]); w.w = pk2(m[6], m[7]);
                const bf16x8 af = __builtin_bit_cast(bf16x8, w);
#pragma unroll
                for (int pb = 0; pb < 2; ++pb) { lptr p = Xn + (16 * ks + 8 * hi) * RSX + (hl * 64 + 32 * pb) * 2 + tro_x; const bf16x8 xf = trfrag(p, p + 4 * RSX); acc[pb] = MFMA32(xf, af, acc[pb]); }
            }
#pragma unroll
            for (int pb = 0; pb < 2; ++pb)
#pragma unroll
                for (int gq = 0; gq < 4; ++gq) { const int pc = hl * 64 + 32 * pb + 8 * gq + 4 * hi;
                    const unsigned long long xw = *(const LAS unsigned long long*)(Xn + q * RSX + pc * 2);
                    const float y0 = acc[pb][4 * gq] + dsk * bflo((unsigned)xw), y1 = acc[pb][4 * gq + 1] + dsk * bfhi((unsigned)xw), y2 = acc[pb][4 * gq + 2] + dsk * bflo((unsigned)(xw >> 32)), y3 = acc[pb][4 * gq + 3] + dsk * bfhi((unsigned)(xw >> 32));
                    *(unsigned long long*)(Y + (row0 + q) * DIN + g * 512 + r * 256 + pc) = (unsigned long long)pk2(y0, y1) | ((unsigned long long)pk2(y2, y3) << 32); }
        }
    }
    __builtin_amdgcn_fence(__ATOMIC_RELEASE, "workgroup");
    __syncthreads();
    __builtin_amdgcn_fence(__ATOMIC_ACQUIRE, "workgroup");
#ifdef PROBE_P4
    const unsigned long long tp2_ = __builtin_amdgcn_s_memrealtime();
#endif
    { const float* nw = a.in[8] + g * 512 + lane * 8; const f32x4 w0 = *(const f32x4*)nw, w1 = *(const f32x4*)(nw + 4);
      for (int t4 = wid * 16; t4 < wid * 16 + 16; t4 += 4) {
        u32x4 yv[4], zv[4];
#pragma unroll
        for (int k = 0; k < 4; ++k) { yv[k] = *(const u32x4*)(Y + (row0 + t4 + k) * DIN + g * 512 + lane * 8); zv[k] = *(const u32x4*)(srow + (size_t)(t4 + k) * NPROJ + OFF_Z + g * 512 + lane * 8); }
#pragma unroll
        for (int k = 0; k < 4; ++k) {
            float f[8] = {bflo(yv[k].x), bfhi(yv[k].x), bflo(yv[k].y), bfhi(yv[k].y), bflo(yv[k].z), bfhi(yv[k].z), bflo(yv[k].w), bfhi(yv[k].w)};
            const float zz[8] = {bflo(zv[k].x), bfhi(zv[k].x), bflo(zv[k].y), bfhi(zv[k].y), bflo(zv[k].z), bfhi(zv[k].z), bflo(zv[k].w), bfhi(zv[k].w)};
            float ss = 0.f;
#pragma unroll
            for (int j = 0; j < 8; ++j) { f[j] *= siluf_(zz[j]); ss += f[j] * f[j]; }
            const float rn = __builtin_amdgcn_rsqf(wave_sum(ss) * (1.0f / 512.0f) + EPS);
            u32x4 o; o.x = pk2(f[0] * rn * w0.x, f[1] * rn * w0.y); o.y = pk2(f[2] * rn * w0.z, f[3] * rn * w0.w); o.z = pk2(f[4] * rn * w1.x, f[5] * rn * w1.y); o.w = pk2(f[6] * rn * w1.z, f[7] * rn * w1.w);
            *(u32x4*)(Y + (row0 + t4 + k) * DIN + g * 512 + lane * 8) = o; }
      } }
    __syncthreads();
#ifdef PROBE_P4
    { const unsigned long long tp3_ = __builtin_amdgcn_s_memrealtime();
      const unsigned long long dt_ = (PROBE_P4 == 1) ? (tp1_ - tp0_) : (PROBE_P4 == 2) ? (tp2_ - tp1_) : (tp3_ - tp2_);
      while (__builtin_amdgcn_s_memrealtime() - tp3_ < 4 * dt_) __builtin_amdgcn_s_sleep(4); }
#endif
}

DI void ffn_fixup(const Args& a) {
    bf16_t* H = (bf16_t*)(a.ws + WS_H);
    const float* SBHA = (const float*)(a.ws + WS_SB); const float* SBHG = (const float*)(a.ws + WS_SB + SB_STRIDE); const float* SBT = (const float*)(a.ws + WS_SB + 2 * SB_STRIDE);
    const float* cw = a.in[17]; const float* cb = a.in[18];
    constexpr int NC4 = FFN / 4, NIT = (MTOK / 64) * 2 * NC4;
    for (int it = blockIdx.x * NTHR + threadIdx.x; it < NIT; it += gridDim.x * NTHR) {
        const int c4 = it % NC4, rr = it / NC4, fr = rr & 1, blk = rr >> 1, col = c4 * 4, row = blk * 64 + fr;
        const bool first = ((blk * 64) & (SEQ - 1)) == 0;
        const f32x4 zero = {0.f, 0.f, 0.f, 0.f};
        const f32x4 av = *(const f32x4*)(SBHA + ((size_t)blk * 2 + fr) * FFN + col), gv = *(const f32x4*)(SBHG + ((size_t)blk * 2 + fr) * FFN + col);
        const f32x4 t0 = first ? zero : *(const f32x4*)(SBT + ((size_t)(blk - 1) * 2 + 0) * FFN + col), t1 = first ? zero : *(const f32x4*)(SBT + ((size_t)(blk - 1) * 2 + 1) * FFN + col);
        const f32x4 h0 = *(const f32x4*)(SBHA + ((size_t)blk * 2 + 0) * FFN + col);
        const f32x4 a1 = fr == 1 ? h0 : t1, a2 = fr == 1 ? t1 : t0;
        const f32x4 w0 = *(const f32x4*)(cw + col), w1 = *(const f32x4*)(cw + FFN + col), w2 = *(const f32x4*)(cw + 2 * FFN + col), bs = *(const f32x4*)(cb + col);
        float hv[4];
#pragma unroll
        for (int k = 0; k < 4; ++k) { const float v = bs[k] + w0[k] * a2[k] + w1[k] * a1[k] + w2[k] * av[k]; hv[k] = siluf_(v) * gv[k]; }
        *(unsigned long long*)(H + (size_t)row * FFN + col) = (unsigned long long)pk2(hv[0], hv[1]) | ((unsigned long long)pk2(hv[2], hv[3]) << 32);
    }
}

typedef __attribute__((address_space(1))) unsigned gu32;
#define XB_TMO      128
#define XB_XCNT(j)  (256  + 64 * (j))
#define XB_XSUB(j)  (1280 + 64 * (j))
#define XB_XGEN(j)  (2304 + 64 * (j))
#define XB_TOP      3328
#define XB_TOPGEN   3392
#define XCD_BAR_WORDS 3456
#define XB_SPIN_CAP (1u << 18)

__device__ __forceinline__ unsigned xb_ld(unsigned* p)              { return __hip_atomic_load(p, __ATOMIC_RELAXED, __HIP_MEMORY_SCOPE_AGENT); }
__device__ __forceinline__ unsigned xb_add(unsigned* p, unsigned v) { return __hip_atomic_fetch_add(p, v, __ATOMIC_RELAXED, __HIP_MEMORY_SCOPE_AGENT); }
__device__ __forceinline__ unsigned xb_xcc_id() { return (unsigned)__builtin_amdgcn_s_getreg((3 << 11) | 20) & 0xFu; }
#define XB_SPIN(cond, bar) do { unsigned _sp = 0; while (cond) { __builtin_amdgcn_s_sleep(1); \
    if ((++_sp & 255u) == 0u) { if (xb_ld(&(bar)[XB_TMO])) break; if (_sp > XB_SPIN_CAP) { atomicAdd(&(bar)[XB_TMO], 1u); break; } } } } while (0)

struct XcdBarrier {
    unsigned* bar; unsigned x;
    volatile LAS unsigned* st;
};

__device__ __forceinline__ XcdBarrier xcd_barrier_post(unsigned* bar, volatile LAS unsigned* st) {
    XcdBarrier b; b.bar = bar; b.x = xb_xcc_id(); b.st = st;
    if (threadIdx.x == 0) (void)xb_add(&bar[XB_XCNT(b.x)], 1u);
    return b;
}
__device__ __forceinline__ void xcd_barrier_complete(unsigned* bar, unsigned x, unsigned& nloc, unsigned& nx) {
    const unsigned G = gridDim.x * gridDim.y * gridDim.z;
    unsigned sum, cnt, mine, sp = 0u;
    for (;;) {
        sum = 0u; cnt = 0u; mine = 0u;
#pragma unroll
        for (unsigned j = 0; j < 16; ++j) { const unsigned c = xb_ld(&bar[XB_XCNT(j)]); sum += c; cnt += (c > 0u) ? 1u : 0u; mine = (j == x) ? c : mine; }
        if (sum == G) break;
        __builtin_amdgcn_s_sleep(1);
        if ((++sp & 255u) == 0u) { if (xb_ld(&bar[XB_TMO])) break; if (sp > XB_SPIN_CAP) { atomicAdd(&bar[XB_TMO], 1u); break; } }
    }
    nloc = mine > 0u ? mine : 1u; nx = cnt > 0u ? cnt : 1u;
}

__device__ __forceinline__ void xcd_barrier(const XcdBarrier& b) {
    asm volatile("s_waitcnt vmcnt(0)" ::: "memory");
    __syncthreads();
    if (threadIdx.x == 0) {
        unsigned* bar = b.bar;
        __builtin_amdgcn_s_waitcnt(0);
        unsigned nloc = b.st[0], nx = b.st[1];
        if (nloc == 0u) { xcd_barrier_complete(bar, b.x, nloc, nx); b.st[0] = nloc; b.st[1] = nx; }
        const unsigned old = xb_add(&bar[XB_XSUB(b.x)], 1u);
        const unsigned gen = old / nloc;
        if (old + 1u == (gen + 1u) * nloc) {
            __builtin_amdgcn_fence(__ATOMIC_RELEASE, "agent");
            asm volatile("s_waitcnt vmcnt(0)" ::: "memory");
            const unsigned og = xb_add(&bar[XB_TOP], 1u);
            const unsigned tg = og / nx;
            if (og + 1u == (tg + 1u) * nx) xb_add(&bar[XB_TOPGEN], 1u);
            else XB_SPIN(xb_ld(&bar[XB_TOPGEN]) == tg, bar);
            __builtin_amdgcn_fence(__ATOMIC_ACQUIRE, "agent");
            xb_add(&bar[XB_XGEN(b.x)], 1u);
            asm volatile("s_waitcnt vmcnt(0)" ::: "memory");
        } else {
            XB_SPIN(xb_ld(&bar[XB_XGEN(b.x)]) == gen, bar);
            __builtin_amdgcn_fence(__ATOMIC_ACQUIRE, "agent");
            asm volatile("s_waitcnt vmcnt(0)" ::: "memory");
        }
    }
    __syncthreads();
}

#ifndef GALIGN
#define GALIGN true
#endif
#ifndef GSP2
#define GSP2 true
#endif
#ifndef PHMASK
#define PHMASK 0x3ff
#endif
#ifndef PHREP
#define PHREP 0
#endif
__global__ void __launch_bounds__(NTHR, 2) mk_fwd(Args args) {
    extern __shared__ __attribute__((aligned(16))) unsigned char lds_raw[];
    lptr lds = (lptr)lds_raw;
    const int G = gridDim.x, bx = blockIdx.x;
    const int vcu = (G % 8 == 0) ? (bx % 8) * (G / 8) + bx / 8 : bx;
    unsigned char* ws = args.ws;
    const int lo = args.ph_lo, hi = args.ph_hi;
    volatile LAS unsigned* bst = (volatile LAS unsigned*)(lds + LDS_BYTES - 16);
    if (threadIdx.x < 4) bst[threadIdx.x] = 0u;
    __syncthreads();
    XcdBarrier bar; bar.bar = (unsigned*)(ws + WS_CTL + CTL_BAR); bar.x = 0; bar.st = bst;
    if (hi - lo > 1) bar = xcd_barrier_post((unsigned*)(ws + WS_CTL + CTL_BAR), bst);
    if (hi < 0) cg::this_grid().sync();
#define IN(k) (((PHMASK >> (k)) & 1) && lo <= (k) && (k) < hi)
#define SEAM(k) do { if (IN(k) && IN((k) + 1)) xcd_barrier(bar); } while (0)
#define REP(k) for (int rp_ = 0; rp_ < ((((PHREP) >> (k)) & 1) ? 2 : 1); ++rp_)
#define REPSYNC() do { if (rp_) xcd_barrier(bar); } while (0)
#ifdef NSYNC
    for (int i_ = 0; i_ < NSYNC; ++i_) xcd_barrier(bar);
#endif
    REP(0) { REPSYNC(); if (IN(0)) { p0_prologue(args, lds, vcu, G); __syncthreads(); } }
    SEAM(0);
#ifndef STAGGER_TICKS
#define STAGGER_TICKS 0
#endif
#define RUN_P1() do { if (IN(1)) { \
        if (STAGGER_TICKS) { const unsigned long long t0_ = __builtin_amdgcn_s_memrealtime(), dl_ = (unsigned long long)bar.x * STAGGER_TICKS; while (__builtin_amdgcn_s_memrealtime() - t0_ < dl_) __builtin_amdgcn_s_sleep(8); } \
        pg8::Gemm g{(const bf16_t*)(ws + WS_U), (const bf16_t*)(ws + WS_WIN), MTOK, OFF_DT, DM}; pg8::StaticOrder S; S.init(MTOK, OFF_DT, G, bx); \
        pg8::Epi<0> E{(bf16_t*)(ws + WS_PROJ), nullptr, nullptr, nullptr, nullptr, nullptr, NPROJ, 0, 0}; \
        pg8::gemm_phase<pg8::Epi<0>, pg8::StaticOrder, GALIGN, GSP2>(lds, g, S, E); \
        dt_gemm(args, lds, vcu, G); } } while (0)
    RUN_P1();
#if (PHREP >> 1) & 1
    xcd_barrier(bar); RUN_P1();
#endif
    SEAM(1);
    if (IN(2)) {
        const bool s1first = (bx >> 3) & 1;
        if (s1first) { for (int u = vcu; u < 512; u += G) ssd_states_unit(args, lds, u >> 8, (u >> 3) & 31, u & 7); }
        for (int v = vcu; v < 256; v += G) { const int bh = v >> 3, s = v & 7;
            attn_unit(args, lds, bh >> 4, bh & 15, 15 - s); attn_unit(args, lds, bh >> 4, bh & 15, s); }
        if (!s1first) { for (int u = vcu; u < 512; u += G) ssd_states_unit(args, lds, u >> 8, (u >> 3) & 31, u & 7); }
    }
    SEAM(2);
    if (IN(3)) ssd_scan(args);
    SEAM(3);
    if (IN(4)) { for (int u = vcu; u < 512; u += G) ssd_out_unit(args, lds, u >> 8, (u >> 3) & 31, u & 7); }
#if (PHREP >> 4) & 1
    xcd_barrier(bar); if (IN(4)) { for (int u = vcu; u < 512; u += G) ssd_out_unit(args, lds, u >> 8, (u >> 3) & 31, u & 7); }
#endif
    SEAM(4);
#define RUN_P5() do { if (IN(5)) { \
        { pg8::Gemm g{(const bf16_t*)(ws + WS_Y), (const bf16_t*)(ws + WS_WSSM), MTOK, DM, DIN}; pg8::StaticOrder S; S.init(MTOK, DM, G, bx); \
          pg8::Epi<1> E{nullptr, args.out, nullptr, (const bf16_t*)(ws + WS_PROJ), args.in[11], nullptr, DM, NPROJ, OFF_G}; \
          pg8::gemm_phase<pg8::Epi<1>, pg8::StaticOrder, GALIGN, GSP2>(lds, g, S, E); } \
        __syncthreads(); \
        { pg8::Gemm g{(const bf16_t*)(ws + WS_U), (const bf16_t*)(ws + WS_WATT), MTOK, DM, DM}; pg8::StaticOrder S; S.init(MTOK, DM, G, bx); \
          pg8::Epi<2> E{(bf16_t*)(ws + WS_MIX), args.out, nullptr, (const bf16_t*)(ws + WS_PROJ), args.in[11] + DM, nullptr, DM, NPROJ, OFF_G + DM}; \
          pg8::gemm_phase<pg8::Epi<2>, pg8::StaticOrder, GALIGN, GSP2>(lds, g, S, E); } } } while (0)
    RUN_P5();
#if (PHREP >> 5) & 1
    xcd_barrier(bar); RUN_P5();
#endif
    SEAM(5);
    if (IN(6)) {
        pg8::Gemm g{(const bf16_t*)(ws + WS_MIX), (const bf16_t*)(ws + WS_WO), MTOK, DM, DM}; pg8::StaticOrder S; S.init(MTOK, DM, G, bx);
        pg8::Epi<3> E{(bf16_t*)(ws + WS_U), args.out, args.in[0], nullptr, args.in[15], (float*)(ws + WS_CTL + CTL_ROWSS), DM, 0, 0};
        pg8::gemm_phase<pg8::Epi<3>, pg8::StaticOrder, GALIGN, GSP2>(lds, g, S, E);
    }
    SEAM(6);
#define RUN_P7() do { if (IN(7)) { \
        pg8::Gemm g{(const bf16_t*)(ws + WS_U), (const bf16_t*)(ws + WS_WUP), MTOK, NUP, DM}; pg8::StaticOrder S; S.init(MTOK, NUP, G, bx); \
        pg8::EpiFfn E{(bf16_t*)(ws + WS_H), (const float*)(ws + WS_CTL + CTL_ROWSS), args.in[17], args.in[18], (float*)(ws + WS_SB), (float*)(ws + WS_SB + SB_STRIDE), (float*)(ws + WS_SB + 2 * SB_STRIDE)}; \
        pg8::gemm_phase<pg8::EpiFfn, pg8::StaticOrder, GALIGN, GSP2>(lds, g, S, E); \
        { const int nwg_ = (MTOK / 256) * (NUP / 256), rem_ = nwg_ % G, nidle_ = rem_ ? G - rem_ : G, first_ = rem_ ? rem_ : 0;     \
          if (bx >= first_) wdn_convert(args, lds, (bx - first_) * NWAVES + (int)(threadIdx.x >> 6), nidle_ * NWAVES); } } } while (0)
    RUN_P7();
#if (PHREP >> 7) & 1
    xcd_barrier(bar); RUN_P7();
#endif
    SEAM(7);
    REP(8) { REPSYNC(); if (IN(8)) ffn_fixup(args); }
    SEAM(8);
    if (IN(9)) {
        pg8::Gemm g{(const bf16_t*)(ws + WS_H), (const bf16_t*)(ws + WS_WDN), MTOK, DM, FFN}; pg8::StaticOrder S; S.init(MTOK, DM, G, bx);
        pg8::Epi<5> E{nullptr, args.out, nullptr, nullptr, nullptr, nullptr, DM, 0, 0};
        pg8::gemm_phase<pg8::Epi<5>, pg8::StaticOrder, GALIGN, GSP2>(lds, g, S, E);
    }
#undef IN
#undef SEAM
}

extern "C" void kernel_launch(void* const* d_in, const int* in_sizes, int n_in, void* d_out, int out_size, void* d_ws, size_t ws_size, hipStream_t stream) {
    static int grid = 0;
    if (grid == 0) {
        if (n_in != 20 || out_size != MTOK * DM || ws_size < WS_END) { fprintf(stderr, "kernel_launch: unexpected shapes (n_in %d out %d ws %zu)\n", n_in, out_size, ws_size); grid = -1; return; }
        int dev = 0, cus = 0, per_cu = 0;
        hipGetDevice(&dev); hipDeviceGetAttribute(&cus, hipDeviceAttributeMultiprocessorCount, dev);
        if (hipFuncSetAttribute((const void*)mk_fwd, hipFuncAttributeMaxDynamicSharedMemorySize, LDS_BYTES) != hipSuccess) { fprintf(stderr, "kernel_launch: hipFuncSetAttribute failed\n"); grid = -1; return; }
        if (hipOccupancyMaxActiveBlocksPerMultiprocessor(&per_cu, (const void*)mk_fwd, NTHR, LDS_BYTES) != hipSuccess || per_cu < 1) { fprintf(stderr, "kernel_launch: occupancy query says %d\n", per_cu); per_cu = 1; }
        (void)hipGetLastError();
        grid = cus * 1;
        fprintf(stderr, "kernel_launch: grid %d (cus %d, per_cu %d)\n", grid, cus, per_cu);
    }
    if (grid < 0) return;
    Args a{};
    for (int i = 0; i < 20; ++i) a.in[i] = (const float*)d_in[i];
    a.out = (float*)d_out; a.ws = (unsigned char*)d_ws;
#if MK_N_LAUNCHES == 1
    if (hipMemsetAsync((char*)d_ws + WS_CTL + CTL_BAR, 0, CTL_BAR_BYTES, stream) != hipSuccess) { fprintf(stderr, "kernel_launch: memset of the barrier words failed\n"); return; }
#ifdef XMEMSET
    for (int i_ = 0; i_ < XMEMSET; ++i_) (void)hipMemsetAsync((char*)d_ws + WS_CTL + CTL_BAR + CTL_BAR_BYTES * (1 + i_), 0, CTL_BAR_BYTES, stream);
#endif
    a.ph_lo = 0; a.ph_hi = 10;
    void* kargs[] = {&a};
    hipError_t e = hipLaunchCooperativeKernel((const void*)mk_fwd, dim3(grid), dim3(NTHR), kargs, LDS_BYTES, stream);
    if (e != hipSuccess) fprintf(stderr, "kernel_launch: cooperative launch failed: %s\n", hipGetErrorString(e));
#else
    for (int ph = 0; ph < 10; ++ph) { a.ph_lo = ph; a.ph_hi = ph + 1; hipLaunchKernelGGL(mk_fwd, dim3(grid), dim3(NTHR), LDS_BYTES, stream, a); }
#endif
}
```
